# Optimizing an MI355X kernel written in HIP

```python
import math, functools
import jax, jax.numpy as jnp
from jax import lax
import numpy as np

D_MODEL = 2048
BATCH = 4
SEQ = 8192
DEPTH = 1
DEC_BATCH = 1
DEC_SEQ = 16384
PAST_LEN = 128

SSM_WIDTH = D_MODEL // 2
SSM_GROUP = 16
SSM_GROUPS = SSM_WIDTH // SSM_GROUP
SSM_STATE = 64
HEAD_DIM = 128
HEADS_PER_GROUP = 4
DILATED_PATTERNS = ((128, 1), (512, 4), (2048, 16))
N_ATTN_GROUPS = len(DILATED_PATTERNS)
ATTN_HEADS = N_ATTN_GROUPS * HEADS_PER_GROUP
ATTN_WIDTH = ATTN_HEADS * HEAD_DIM
ATTN_OUT_WIDTH = HEADS_PER_GROUP * HEAD_DIM
REL_BUCKETS = 32
REL_MAX_DIST = 1024
D_FF = 4 * D_MODEL
Q_OFF = SSM_WIDTH
K_OFF = Q_OFF + ATTN_WIDTH
V_OFF = K_OFF + ATTN_WIDTH
G_OFF = V_OFF + ATTN_WIDTH
IN_COLS = G_OFF + 2 * D_MODEL
RMS_EPS = 1e-6
NEG_INF = -1e30

kernel_name = 'hybrid_s5_dilated_attn_encoder'


def rms_norm(x, g):
    x32 = x.astype(jnp.float32)
    y = x32 * lax.rsqrt(jnp.mean(x32 * x32, axis=-1, keepdims=True) + RMS_EPS)
    return (y * g.astype(jnp.float32)).astype(x.dtype)


def t5_bucket(rel):
    nb = REL_BUCKETS // 2
    max_exact = nb // 2
    ret = jnp.where(rel > 0, nb, 0)
    n = jnp.abs(rel)
    nf = jnp.maximum(n, 1).astype(jnp.float32)
    large = max_exact + (jnp.log(nf / max_exact) / math.log(REL_MAX_DIST / max_exact) * (nb - max_exact)).astype(jnp.int32)
    large = jnp.minimum(large, nb - 1)
    return ret + jnp.where(n < max_exact, n, large)


def s5_direction(u, a_re, a_im, log_dt, b_re, b_im, c_re, c_im, reverse):
    lam = lax.complex(a_re.astype(jnp.float32), a_im.astype(jnp.float32))
    dt = jnp.exp(log_dt.astype(jnp.float32))[:, None]
    a_bar = jnp.exp(lam * dt)
    b = lax.complex(b_re.astype(jnp.float32), b_im.astype(jnp.float32))
    b_bar = ((a_bar - 1.0) / lam)[..., None] * b
    bu = lax.complex(jnp.einsum('blgc,gpc->blgp', u, jnp.real(b_bar)),
                     jnp.einsum('blgc,gpc->blgp', u, jnp.imag(b_bar)))
    a_seq = jnp.broadcast_to(a_bar, bu.shape)

    def combine(left, right):
        return (left[0] * right[0], right[0] * left[1] + right[1])

    _, h = lax.associative_scan(combine, (a_seq, bu), axis=1, reverse=reverse)
    return (jnp.einsum('blgp,gcp->blgc', jnp.real(h), c_re.astype(jnp.float32))
            - jnp.einsum('blgp,gcp->blgc', jnp.imag(h), c_im.astype(jnp.float32)))


def dilated_window_attention(q, k, v, bias_table, window, dilation):
    bsz, seqlen, hg, hd = q.shape
    half = window // (2 * dilation)
    m = seqlen // dilation
    nblk = -(-m // half)
    mp = nblk * half

    def to_sub(t):
        return t.reshape(bsz, m, dilation, hg, hd).transpose(0, 2, 1, 3, 4).reshape(bsz * dilation, m, hg, hd)

    def from_sub(t):
        rest = t.shape[3:]
        t = t.reshape((bsz * dilation, mp) + rest)[:, :m]
        t = t.reshape((bsz, dilation, m) + rest)
        return jnp.swapaxes(t, 1, 2).reshape((bsz, seqlen) + rest)

    def key_blocks(t):
        tp = jnp.pad(to_sub(t), ((0, 0), (half, mp - m + half), (0, 0), (0, 0)))
        tp = tp.reshape(-1, nblk + 2, half, hg, hd)
        return jnp.concatenate([tp[:, :-2], tp[:, 1:-1], tp[:, 2:]], axis=2)

    qs = jnp.pad(to_sub(q), ((0, 0), (0, mp - m), (0, 0), (0, 0))).reshape(-1, nblk, half, hg, hd)
    kb = key_blocks(k)
    vb = key_blocks(v)

    qi = jnp.arange(half)[:, None]
    ki = jnp.arange(3 * half)[None, :]
    rel = ki - half - qi
    bias = bias_table[t5_bucket(rel * dilation)].astype(jnp.float32).transpose(2, 0, 1)
    key_idx = jnp.arange(nblk)[:, None, None] * half + (ki - half)[None]
    valid = (jnp.abs(rel) <= half)[None] & (key_idx >= 0) & (key_idx < m)

    s = jnp.einsum('bnqhd,bnkhd->bnhqk', qs, kb) * (hd ** -0.5) + bias[None, None]
    s = jnp.where(valid[None, :, None], s, NEG_INF)
    smax = jnp.max(s, axis=-1, keepdims=True)
    p = jnp.exp(s - smax)
    den = jnp.sum(p, axis=-1, keepdims=True)
    o = jnp.einsum('bnhqk,bnkhd->bnhqd', p, vb) / den
    lse = (smax + jnp.log(den))[..., 0]
    o = from_sub(o.transpose(0, 1, 3, 2, 4))
    lse = from_sub(lse.transpose(0, 1, 3, 2))
    return o, lse


def encoder_layer(x, norm1_g, w_in, ssm_a_re, ssm_a_im, ssm_log_dt, ssm_b_re, ssm_b_im, ssm_c_re, ssm_c_im,
                  ssm_d, w_glu, b_glu, w_br_ssm, w_br_attn, w_out, norm2_g, w_ff1, w_ff2, rel_bias):
    bsz, seqlen, _ = x.shape
    xn = rms_norm(x, norm1_g)
    proj = jnp.einsum('bld,dc->blc', xn, w_in)
    u = proj[..., :Q_OFF].astype(jnp.float32).reshape(bsz, seqlen, SSM_GROUPS, SSM_GROUP)
    q = proj[..., Q_OFF:K_OFF].astype(jnp.float32).reshape(bsz, seqlen, ATTN_HEADS, HEAD_DIM)
    k = proj[..., K_OFF:V_OFF].astype(jnp.float32).reshape(bsz, seqlen, ATTN_HEADS, HEAD_DIM)
    v = proj[..., V_OFF:G_OFF].astype(jnp.float32).reshape(bsz, seqlen, ATTN_HEADS, HEAD_DIM)
    g_ssm = jax.nn.sigmoid(proj[..., G_OFF:G_OFF + D_MODEL].astype(jnp.float32))
    g_attn = jax.nn.sigmoid(proj[..., G_OFF + D_MODEL:].astype(jnp.float32))

    y = ssm_d.astype(jnp.float32).reshape(SSM_GROUPS, SSM_GROUP) * u
    for direction in range(2):
        y = y + s5_direction(u, ssm_a_re[direction], ssm_a_im[direction], ssm_log_dt[direction],
                             ssm_b_re[direction], ssm_b_im[direction], ssm_c_re[direction], ssm_c_im[direction],
                             reverse=bool(direction))
    z = jax.nn.gelu(y.reshape(bsz, seqlen, SSM_WIDTH))
    y_ssm = z * jax.nn.sigmoid(jnp.einsum('blc,ce->ble', z, w_glu) + b_glu)
    branch_ssm = jnp.einsum('blc,cd->bld', y_ssm, w_br_ssm)

    outs, lses = [], []
    for gi, (window, dilation) in enumerate(DILATED_PATTERNS):
        hs = slice(gi * HEADS_PER_GROUP, (gi + 1) * HEADS_PER_GROUP)
        o, l = dilated_window_attention(q[:, :, hs], k[:, :, hs], v[:, :, hs], rel_bias[:, hs], window, dilation)
        outs.append(o)
        lses.append(l)
    outs = jnp.stack(outs, axis=0)
    weights = jax.nn.softmax(jnp.stack(lses, axis=0), axis=0)
    y_attn = jnp.sum(weights[..., None] * outs, axis=0).reshape(bsz, seqlen, ATTN_OUT_WIDTH)
    branch_attn = jnp.einsum('blc,cd->bld', y_attn, w_br_attn)

    mixed = g_ssm * branch_ssm + g_attn * branch_attn
    h = x + jnp.einsum('bld,de->ble', mixed, w_out)

    hn = rms_norm(h, norm2_g)
    act = jnp.square(jax.nn.relu(jnp.einsum('bld,df->blf', hn, w_ff1)))
    return h + jnp.einsum('blf,fd->bld', act, w_ff2)


def encoder_trunk(x, norm1_g, w_in, ssm_a_re, ssm_a_im, ssm_log_dt, ssm_b_re, ssm_b_im, ssm_c_re, ssm_c_im,
                  ssm_d, w_glu, b_glu, w_br_ssm, w_br_attn, w_out, norm2_g, w_ff1, w_ff2, rel_bias, final_g):
    for layer in range(DEPTH):
        x = encoder_layer(x, norm1_g[layer], w_in[layer], ssm_a_re[layer], ssm_a_im[layer], ssm_log_dt[layer],
                          ssm_b_re[layer], ssm_b_im[layer], ssm_c_re[layer], ssm_c_im[layer], ssm_d[layer],
                          w_glu[layer], b_glu[layer], w_br_ssm[layer], w_br_attn[layer], w_out[layer],
                          norm2_g[layer], w_ff1[layer], w_ff2[layer], rel_bias)
    return rms_norm(x, final_g)


def setup_inputs(seed: int = 0) -> dict:
    key = jax.random.key(seed)
    ks = jax.random.split(key, 24)
    f32 = jnp.float32

    def nrm(k, shape, scale):
        return jax.random.normal(k, shape, f32) * scale

    g2 = (DEPTH, 2, SSM_GROUPS)
    a_im_base = jnp.pi * jnp.arange(SSM_STATE, dtype=f32)
    return {
        'x_prompt': nrm(ks[0], (BATCH, SEQ, D_MODEL), 1.0),
        'x_sample': nrm(ks[1], (DEC_BATCH, DEC_SEQ, D_MODEL), 1.0),
        'norm1_g': 1.0 + nrm(ks[2], (DEPTH, D_MODEL), 0.01),
        'w_in': nrm(ks[3], (DEPTH, D_MODEL, IN_COLS), D_MODEL ** -0.5),
        'ssm_a_re': -0.5 + nrm(ks[4], g2 + (SSM_STATE,), 0.02),
        'ssm_a_im': a_im_base + nrm(ks[5], g2 + (SSM_STATE,), 0.02),
        'ssm_log_dt': jax.random.uniform(ks[6], g2, f32, math.log(1e-3), math.log(1e-1)),
        'ssm_b_re': nrm(ks[7], g2 + (SSM_STATE, SSM_GROUP), (2 * SSM_GROUP) ** -0.5),
        'ssm_b_im': nrm(ks[8], g2 + (SSM_STATE, SSM_GROUP), (2 * SSM_GROUP) ** -0.5),
        'ssm_c_re': nrm(ks[9], g2 + (SSM_GROUP, SSM_STATE), SSM_STATE ** -0.5),
        'ssm_c_im': nrm(ks[10], g2 + (SSM_GROUP, SSM_STATE), SSM_STATE ** -0.5),
        'ssm_d': nrm(ks[11], (DEPTH, SSM_WIDTH), 1.0),
        'w_glu': nrm(ks[12], (DEPTH, SSM_WIDTH, SSM_WIDTH), SSM_WIDTH ** -0.5),
        'b_glu': nrm(ks[13], (DEPTH, SSM_WIDTH), 0.01),
        'w_br_ssm': nrm(ks[14], (DEPTH, SSM_WIDTH, D_MODEL), SSM_WIDTH ** -0.5),
        'w_br_attn': nrm(ks[15], (DEPTH, ATTN_OUT_WIDTH, D_MODEL), ATTN_OUT_WIDTH ** -0.5),
        'w_out': nrm(ks[16], (DEPTH, D_MODEL, D_MODEL), D_MODEL ** -0.5),
        'norm2_g': 1.0 + nrm(ks[17], (DEPTH, D_MODEL), 0.01),
        'w_ff1': nrm(ks[18], (DEPTH, D_MODEL, D_FF), D_MODEL ** -0.5),
        'w_ff2': nrm(ks[19], (DEPTH, D_FF, D_MODEL), D_FF ** -0.5),
        'rel_bias': nrm(ks[20], (REL_BUCKETS, ATTN_HEADS), 0.5),
        'final_g': 1.0 + nrm(ks[21], (D_MODEL,), 0.01),
    }


def reference(x_prompt, x_sample, norm1_g, w_in, ssm_a_re, ssm_a_im, ssm_log_dt, ssm_b_re, ssm_b_im, ssm_c_re,
              ssm_c_im, ssm_d, w_glu, b_glu, w_br_ssm, w_br_attn, w_out, norm2_g, w_ff1, w_ff2, rel_bias, final_g):
    run = functools.partial(encoder_trunk, norm1_g=norm1_g, w_in=w_in, ssm_a_re=ssm_a_re, ssm_a_im=ssm_a_im,
                            ssm_log_dt=ssm_log_dt, ssm_b_re=ssm_b_re, ssm_b_im=ssm_b_im, ssm_c_re=ssm_c_re,
                            ssm_c_im=ssm_c_im, ssm_d=ssm_d, w_glu=w_glu, b_glu=b_glu, w_br_ssm=w_br_ssm,
                            w_br_attn=w_br_attn, w_out=w_out, norm2_g=norm2_g, w_ff1=w_ff1, w_ff2=w_ff2,
                            rel_bias=rel_bias, final_g=final_g)
    y_prompt = run(x_prompt)
    y_sample = run(x_sample)
    return (y_prompt, y_sample)
```

```cpp
#include <hip/hip_runtime.h>
#include <hip/hip_cooperative_groups.h>
#include <cstdio>
#include <cstdint>
namespace cg = cooperative_groups;

#ifndef MK_COOP
#define MK_COOP 1
#endif

#ifndef USE_CG_ALL
#define USE_CG_ALL 1
#endif
#ifndef PROBE_MASK
#define PROBE_MASK 0u
#endif
#define LAS __attribute__((address_space(3)))
typedef unsigned short bf16_t;
typedef short bf16x8 __attribute__((ext_vector_type(8)));
typedef short s16x4 __attribute__((ext_vector_type(4)));
typedef float f32x4 __attribute__((ext_vector_type(4)));
typedef unsigned u32x4 __attribute__((ext_vector_type(4)));
typedef unsigned u32x2 __attribute__((ext_vector_type(2)));

constexpr int M_TOK = 49152, DM = 2048, SSMW = 1024, QKVW = 4608, GATEW = 4096, DFF = 8192;
constexpr int NCHUNK = M_TOK / 16;
constexpr int FF_ROWS = 24576, N_FFC = 2;
constexpr int N_PHASES = 10 + 2 * N_FFC + 1;
constexpr int LDS_BYTES = 131072 + 16;

constexpr size_t WS_ASSM = 0;
constexpr size_t WS_QKV = 201326592;
constexpr size_t WS_GATES = WS_QKV + 452984832;
constexpr size_t WS_LSE = WS_GATES + 402653184;
constexpr size_t WS_BIAS = WS_LSE + 2359296;
constexpr size_t WS_BAR = WS_BIAS + 8192;
constexpr size_t WS_END = WS_BAR + 16384;
constexpr size_t DO_WIN = 0, DO_WGLU = 39845888, DO_WBS = 41943040, DO_WBA = 46137344, DO_WOUT = 48234496, DO_WFF1 = 56623104, DO_WFF2 = 90177536;
constexpr size_t DO_BTY = 123731968;
constexpr size_t DO_BTS = 140509184;
constexpr size_t DO_XN = 148897792;
constexpr size_t DO_YATT = 350224384;

__device__ __forceinline__ unsigned cvt_pk_bf16(float lo, float hi) { unsigned r; asm("v_cvt_pk_bf16_f32 %0, %1, %2" : "=v"(r) : "v"(lo), "v"(hi)); return r; }
__device__ __forceinline__ bf16_t f2bf(float f) { unsigned u = __float_as_uint(f); u += 0x7FFFu + ((u >> 16) & 1u); return (bf16_t)(u >> 16); }
__device__ __forceinline__ float bflo(unsigned w) { return __uint_as_float(w << 16); }
__device__ __forceinline__ float bfhi(unsigned w) { return __uint_as_float(w & 0xffff0000u); }
__device__ __forceinline__ void unpack8(const u32x4 w, f32x4& a, f32x4& b) { a = (f32x4){bflo(w.x), bfhi(w.x), bflo(w.y), bfhi(w.y)}; b = (f32x4){bflo(w.z), bfhi(w.z), bflo(w.w), bfhi(w.w)}; }
__device__ __forceinline__ u32x4 pack8(const f32x4 a, const f32x4 b) { u32x4 w; w.x = cvt_pk_bf16(a[0], a[1]); w.y = cvt_pk_bf16(a[2], a[3]); w.z = cvt_pk_bf16(b[0], b[1]); w.w = cvt_pk_bf16(b[2], b[3]); return w; }
__device__ __forceinline__ float sigmoidf_(float x) { return 1.0f / (1.0f + __expf(-x)); }
__device__ __forceinline__ float gelu_tanh(float x) { const float y = 0.7978845608028654f * (x + 0.044715f * x * x * x); return x / (1.0f + __expf(-2.0f * y)); }

__device__ __forceinline__ int ltid() { int t = threadIdx.x; asm volatile("" : "+v"(t)); return t; }
__device__ __forceinline__ size_t opaque_zero() { size_t z = 0; asm volatile("" : "+s"(z)); return z; }
template <class T> __device__ __forceinline__ T* lptr(T* p) { return (T*)((unsigned char*)p + opaque_zero()); }
namespace pg8 {
constexpr int BM = 256, BK = 64, HALF = 128, HTB = HALF * BK * 2, NXCD = 8, WGM = 4;
__device__ __forceinline__ int lds_byte(int r, int c) { const int st = (r >> 4) * 2 + (c >> 5), rr = r & 15, cc = c & 31, ob = rr * 64 + cc * 2; return st * 1024 + (ob ^ (((ob >> 9) & 1) << 5)); }
__device__ __forceinline__ void stage_rc(int b, int& R, int& C) { const int st = b / 1024, sb = b % 1024, swz = sb ^ (((sb >> 9) & 1) << 5); R = (st >> 1) * 16 + swz / 64; C = (st & 1) * 32 + (swz % 64) / 2; }
__device__ __forceinline__ int perm32(int rho) { const int n = rho >> 4, i = rho & 15; return 8 * (i >> 2) + 4 * n + (i & 3); }

struct Unit { int pm, pn; };
struct GemmD { const bf16_t* A; const bf16_t* Bt; int lda, ldb, K; };

struct Sched {
    int nM, nN, nwg, G, c, ssm;
    __device__ __forceinline__ bool next(int i, Unit& u) const {
        const long L = (long)i * G + c; if (L >= nwg) return false;
        if (ssm) { u.pm = (int)L; u.pn = (int)L / 12; return true; }
        int wgid = (int)L; { const int q = nwg / NXCD, r = nwg % NXCD, xcd = wgid % NXCD, off = wgid / NXCD; wgid = (xcd < r ? xcd * (q + 1) : r * (q + 1) + (xcd - r) * q) + off; }
        const int nig = WGM * nN, gid = wgid / nig, fm = gid * WGM, gsz = (nM - fm) < WGM ? (nM - fm) : WGM;
        u.pm = fm + ((wgid % nig) % gsz); u.pn = (wgid % nig) / gsz; return true;
    }
};

enum { EM_INPROJ = 0, EM_SSM_S, EM_SSM_Y, EM_GLU, EM_BR1, EM_BR2, EM_OUT, EM_FF1, EM_FF2 };
struct Epi {
    int mode; unsigned char* ws; unsigned char* dob; const float* bglu; const float* x0; const float* x1; size_t hoff;
};
struct EpiP { bf16_t* assm; bf16_t* qkv; bf16_t* gates; bf16_t* S; bf16_t* z; const float* bglu; bf16_t* yssm; bf16_t* mixed; const float* x0; const float* x1; bf16_t* hb; bf16_t* hfin; bf16_t* act; };

template <int MODE>
__device__ __forceinline__ void epi_body(const Epi& E0, const f32x4 (&acc)[2][2][4][2], const Unit& u, int wr, int wc, int fr, int fq) {
    asm volatile("" : "+v"(fr), "+v"(fq));
    unsigned char* ws = lptr(E0.ws); unsigned char* dob = lptr(E0.dob);
    EpiP E;
    E.assm = (bf16_t*)(ws + WS_ASSM); E.qkv = (bf16_t*)(ws + WS_QKV); E.gates = (bf16_t*)(ws + WS_GATES); E.S = (bf16_t*)(dob + DO_XN); E.z = (bf16_t*)(dob + DO_XN);
    E.bglu = E0.bglu; E.yssm = E.z + (size_t)M_TOK * SSMW; E.mixed = (bf16_t*)(ws + WS_QKV); E.x0 = E0.x0; E.x1 = E0.x1; E.hb = (bf16_t*)(ws + WS_GATES) + E0.hoff; E.hfin = (bf16_t*)(ws + WS_GATES) + (size_t)M_TOK * DM + E0.hoff; E.act = (bf16_t*)(ws + WS_QKV);
    const int row0 = u.pm * BM + wr * 64 + fr, cl0 = wc * 32 + 8 * fq;
#pragma unroll
    for (int ai = 0; ai < 2; ++ai)
#pragma unroll
        for (int m = 0; m < 4; ++m) {
            const int r = row0 + ai * HALF + m * 16;
#pragma unroll
            for (int bj = 0; bj < 2; ++bj) {
                const int cl = cl0 + bj * HALF;
                f32x4 v0 = acc[ai][bj][m][0], v1 = acc[ai][bj][m][1];
                if constexpr (MODE == EM_INPROJ) {
                    if (u.pn < 4) {
                        const int col = u.pn * 256 + cl, g = col >> 4, cc = col & 15, chunk = r >> 4, t = r & 15;
                        *(u32x4*)(E.assm + ((size_t)(g * NCHUNK + chunk) * 512 + t * 16 + cc)) = pack8(v0, v1);
                    } else if (u.pn < 22) {
                        const int hidx = (u.pn - 4) * 2 + bj, tensor = hidx / 12, head = hidx - tensor * 12, dcol = cl & 127, dsh = (head >> 2) * 2;
                        int sbase, lsh; if (r < 32768) { sbase = r & ~8191; lsh = 13; } else { sbase = 32768; lsh = 14; }
                        const int local = r - sbase, perm = sbase + ((local & ((1 << dsh) - 1)) << (lsh - dsh)) + (local >> dsh);
                        *(u32x4*)(E.qkv + ((size_t)hidx * M_TOK + perm) * 128 + dcol) = pack8(v0, v1);
                    } else {
#pragma unroll
                        for (int j = 0; j < 4; ++j) { v0[j] = sigmoidf_(v0[j]); v1[j] = sigmoidf_(v1[j]); }
                        *(u32x4*)(E.gates + (size_t)r * GATEW + (u.pn - 22) * 256 + cl) = pack8(v0, v1);
                    }
                } else if constexpr (MODE == EM_SSM_S) {
                    *(u32x4*)(E.S + (size_t)r * 256 + cl) = pack8(v0, v1);
                } else if constexpr (MODE == EM_SSM_Y) {
                    const int g = u.pm / 12, chunk = r - g * NCHUNK, t = cl >> 4, cc = cl & 15, tok = chunk * 16 + t;
#pragma unroll
                    for (int j = 0; j < 4; ++j) { v0[j] = gelu_tanh(v0[j]); v1[j] = gelu_tanh(v1[j]); }
                    *(u32x4*)(E.z + (size_t)tok * SSMW + g * 16 + cc) = pack8(v0, v1);
                } else if constexpr (MODE == EM_GLU) {
                    const int c = u.pn * 256 + cl; const size_t off = (size_t)r * SSMW + c;
                    f32x4 z0, z1; unpack8(*(const u32x4*)(E.z + off), z0, z1);
                    const f32x4 b0 = *(const f32x4*)(E.bglu + c), b1 = *(const f32x4*)(E.bglu + c + 4);
#pragma unroll
                    for (int j = 0; j < 4; ++j) { v0[j] = z0[j] * sigmoidf_(v0[j] + b0[j]); v1[j] = z1[j] * sigmoidf_(v1[j] + b1[j]); }
                    *(u32x4*)(E.yssm + off) = pack8(v0, v1);
                } else if constexpr (MODE == EM_BR1) {
                    const int c = u.pn * 256 + cl;
                    f32x4 g0, g1; unpack8(*(const u32x4*)(E.gates + (size_t)r * GATEW + c), g0, g1);
                    *(u32x4*)(E.mixed + (size_t)r * DM + c) = pack8(g0 * v0, g1 * v1);
                } else if constexpr (MODE == EM_BR2) {
                    const int c = u.pn * 256 + cl;
                    f32x4 g0, g1, m0, m1; unpack8(*(const u32x4*)(E.gates + (size_t)r * GATEW + DM + c), g0, g1);
                    bf16_t* mp = E.mixed + (size_t)r * DM + c; unpack8(*(const u32x4*)mp, m0, m1);
                    *(u32x4*)mp = pack8(m0 + g0 * v0, m1 + g1 * v1);
                } else if constexpr (MODE == EM_OUT) {
                    const int c = u.pn * 256 + cl;
                    const float* xr = (r < 32768 ? E.x0 + (size_t)r * DM : E.x1 + (size_t)(r - 32768) * DM) + c;
                    *(u32x4*)(E.hb + (size_t)r * DM + c) = pack8(*(const f32x4*)xr + v0, *(const f32x4*)(xr + 4) + v1);
                } else if constexpr (MODE == EM_FF1) {
                    const int c = u.pn * 256 + cl;
#pragma unroll
                    for (int j = 0; j < 4; ++j) { const float a = fmaxf(v0[j], 0.f), b = fmaxf(v1[j], 0.f); v0[j] = a * a; v1[j] = b * b; }
                    *(u32x4*)(E.act + (size_t)r * DFF + c) = pack8(v0, v1);
                } else if constexpr (MODE == EM_FF2) {
                    const int c = u.pn * 256 + cl;
                    f32x4 h0, h1; unpack8(*(const u32x4*)(E.hb + (size_t)r * DM + c), h0, h1);
                    *(u32x4*)(E.hfin + (size_t)r * DM + c) = pack8(h0 + v0, h1 + v1);
                }
            }
        }
}
__device__ __forceinline__ void epi_run(const Epi& E, const f32x4 (&acc)[2][2][4][2], const Unit& u, int wr, int wc, int fr, int fq) {
    switch (E.mode) {
        case EM_INPROJ: epi_body<EM_INPROJ>(E, acc, u, wr, wc, fr, fq); break;
        case EM_SSM_S: epi_body<EM_SSM_S>(E, acc, u, wr, wc, fr, fq); break;
        case EM_SSM_Y: epi_body<EM_SSM_Y>(E, acc, u, wr, wc, fr, fq); break;
        case EM_GLU: epi_body<EM_GLU>(E, acc, u, wr, wc, fr, fq); break;
        case EM_BR1: epi_body<EM_BR1>(E, acc, u, wr, wc, fr, fq); break;
        case EM_BR2: epi_body<EM_BR2>(E, acc, u, wr, wc, fr, fq); break;
        case EM_OUT: epi_body<EM_OUT>(E, acc, u, wr, wc, fr, fq); break;
        case EM_FF1: epi_body<EM_FF1>(E, acc, u, wr, wc, fr, fq); break;
        default: epi_body<EM_FF2>(E, acc, u, wr, wc, fr, fq); break;
    }
}

__device__ __forceinline__ void gemm_phase(LAS unsigned char* lds, const GemmD g, const Sched& S, const Epi& E) {
    const int tid = ltid(), wid = __builtin_amdgcn_readfirstlane(tid >> 6), lane = tid & 63, wr = wid >> 2, wc = wid & 3, fr = lane & 15, fq = lane >> 4;
    const int K = g.K, nt = K / BK;
    unsigned voffA[2], voffB[2];
#pragma unroll
    for (int i = 0; i < 2; ++i) { int R, C; stage_rc(tid * 16 + i * 8192, R, C); const int Rb = (R & ~31) + perm32(R & 31);
        voffA[i] = (unsigned)(R * g.lda + C) * 2u; voffB[i] = (unsigned)(Rb * g.ldb + C) * 2u; }
    const size_t kstep = (size_t)(BK * 2);
    const size_t hstepA = (size_t)HALF * g.lda * 2, tstepA = 2 * hstepA;
    const size_t hstepB = (size_t)HALF * g.ldb * 2, tstepB = 2 * hstepB;
    const unsigned ldsw = (unsigned)wid * 1024u;
    const int aoff = lds_byte(wr * 64 + fr, fq * 8), boff = lds_byte(wc * 32 + fr, fq * 8);
#define PG8_SA(b, h) (((b) * 2 + (h)) * HTB)
#define PG8_SB(b, h) ((4 + (b) * 2 + (h)) * HTB)
#define PG8_STAGE(bufoff, gbase, voff) do { _Pragma("unroll") for (int _i = 0; _i < 2; ++_i) \
        __builtin_amdgcn_global_load_lds((const unsigned*)((const char*)(gbase) + (voff)[_i]), (LAS unsigned*)(lds + (bufoff) + ldsw + _i * 8192), 16, 0, 0); } while (0)
#define PG8_LDA(dst, b, h) do { _Pragma("unroll") for (int m = 0; m < 4; ++m) _Pragma("unroll") for (int k = 0; k < 2; ++k) dst[m][k] = *(const LAS bf16x8*)(lds + PG8_SA(b, h) + aoff + m * 2048 + k * 1024); } while (0)
#define PG8_LDB(dst, b, h) do { _Pragma("unroll") for (int n = 0; n < 2; ++n) _Pragma("unroll") for (int k = 0; k < 2; ++k) dst[n][k] = *(const LAS bf16x8*)(lds + PG8_SB(b, h) + boff + n * 2048 + k * 1024); } while (0)
#define PG8_MMA(ai, bj, At, Bt) do { __builtin_amdgcn_s_setprio(1); _Pragma("unroll") for (int m = 0; m < 4; ++m) _Pragma("unroll") for (int n = 0; n < 2; ++n) _Pragma("unroll") for (int k = 0; k < 2; ++k) \
        acc[ai][bj][m][n] = __builtin_amdgcn_mfma_f32_16x16x32_bf16(Bt[n][k], At[m][k], acc[ai][bj][m][n], 0, 0, 0); __builtin_amdgcn_s_setprio(0); } while (0)
#define PG8_WAIT_V(n) asm volatile("s_waitcnt vmcnt(" #n ")" ::: "memory")
#define PG8_WAIT_L(n) asm volatile("s_waitcnt lgkmcnt(" #n ")" ::: "memory")
#define PG8_BAR __builtin_amdgcn_s_barrier()
#define PG8_SCHED __builtin_amdgcn_sched_barrier(0)
    Unit cur, nxt; int ui = 0;
    if (!S.next(0, cur)) return;
    f32x4 acc[2][2][4][2];
#pragma unroll
    for (int a = 0; a < 2; ++a)
#pragma unroll
        for (int b = 0; b < 2; ++b)
#pragma unroll
            for (int m = 0; m < 4; ++m)
#pragma unroll
                for (int n = 0; n < 2; ++n) acc[a][b][m][n] = (f32x4){0.f, 0.f, 0.f, 0.f};
    bf16x8 At[4][2], B0[2][2], B1[2][2];
    const char* cA = (const char*)g.A + (size_t)cur.pm * tstepA; const char* cB = (const char*)g.Bt + (size_t)cur.pn * tstepB;
    PG8_STAGE(PG8_SB(0, 0), cB, voffB); PG8_STAGE(PG8_SB(0, 1), cB + hstepB, voffB); PG8_STAGE(PG8_SA(0, 0), cA, voffA); PG8_STAGE(PG8_SA(0, 1), cA + hstepA, voffA);
    if (wr == 1) PG8_BAR;
    PG8_WAIT_V(2); PG8_BAR;
    PG8_STAGE(PG8_SB(1, 0), cB + kstep, voffB); PG8_STAGE(PG8_SA(1, 0), cA + kstep, voffA); PG8_STAGE(PG8_SB(1, 1), cB + hstepB + kstep, voffB);
    PG8_WAIT_V(6); PG8_BAR;
    for (;;) {
        const bool has_next = S.next(ui + 1, nxt);
        const char* nA = has_next ? (const char*)g.A + (size_t)nxt.pm * tstepA : cA; const char* nB = has_next ? (const char*)g.Bt + (size_t)nxt.pn * tstepB : cB;
        for (int t = 0; t < nt; t += 2) {
            const bool last = (t == nt - 2);
            const char* a1 = cA + (size_t)(t + 1) * kstep;
            const char* a2 = last ? nA : cA + (size_t)(t + 2) * kstep; const char* b2 = last ? nB : cB + (size_t)(t + 2) * kstep;
            const char* a3 = a2 + kstep; const char* b3 = b2 + kstep;
            PG8_LDB(B0, 0, 0); PG8_LDB(B1, 0, 1); PG8_SCHED; PG8_LDA(At, 0, 0); PG8_STAGE(PG8_SA(1, 1), a1 + hstepA, voffA);
            PG8_WAIT_V(8); PG8_WAIT_L(0); PG8_BAR; PG8_MMA(0, 0, At, B0); PG8_MMA(0, 1, At, B1); PG8_BAR; PG8_SCHED;
            PG8_LDA(At, 0, 1); PG8_STAGE(PG8_SB(0, 0), b2, voffB); PG8_STAGE(PG8_SB(0, 1), b2 + hstepB, voffB); PG8_STAGE(PG8_SA(0, 0), a2, voffA);
            PG8_WAIT_V(8); PG8_WAIT_L(0); PG8_BAR; PG8_MMA(1, 0, At, B0); PG8_MMA(1, 1, At, B1); PG8_BAR; PG8_SCHED;
            PG8_LDB(B0, 1, 0); PG8_LDB(B1, 1, 1); PG8_SCHED; PG8_LDA(At, 1, 0); PG8_STAGE(PG8_SA(0, 1), a2 + hstepA, voffA);
            PG8_WAIT_V(8); PG8_WAIT_L(0); PG8_BAR; PG8_MMA(0, 0, At, B0); PG8_MMA(0, 1, At, B1); PG8_BAR; PG8_SCHED;
            PG8_LDA(At, 1, 1); PG8_STAGE(PG8_SB(1, 0), b3, voffB); PG8_STAGE(PG8_SB(1, 1), b3 + hstepB, voffB); PG8_STAGE(PG8_SA(1, 0), a3, voffA);
            PG8_WAIT_V(8); PG8_WAIT_L(0); PG8_BAR; PG8_MMA(1, 0, At, B0); PG8_MMA(1, 1, At, B1); PG8_BAR; PG8_SCHED;
        }
        if (wr == 0) PG8_BAR;
        epi_run(E, acc, cur, wr, wc, fr, fq);
        if (!has_next) break;
#pragma unroll
        for (int a = 0; a < 2; ++a)
#pragma unroll
            for (int b = 0; b < 2; ++b)
#pragma unroll
                for (int m = 0; m < 4; ++m)
#pragma unroll
                    for (int n = 0; n < 2; ++n) acc[a][b][m][n] = (f32x4){0.f, 0.f, 0.f, 0.f};
        cur = nxt; cA = nA; cB = nB; ++ui;
        if (wr == 1) PG8_BAR;
    }
    PG8_WAIT_V(0);
    PG8_BAR;
#undef PG8_SA
#undef PG8_SB
#undef PG8_STAGE
#undef PG8_LDA
#undef PG8_LDB
#undef PG8_MMA
#undef PG8_WAIT_V
#undef PG8_WAIT_L
#undef PG8_BAR
#undef PG8_SCHED
}
}

#define XB_TMO      128
#define XB_XCNT(j)  (256  + 64 * (j))
#define XB_XSUB(j)  (1280 + 64 * (j))
#define XB_XGEN(j)  (2304 + 64 * (j))
#define XB_TOP      3328
#define XB_TOPGEN   3392
#define XCD_BAR_WORDS 3456
#define XB_SPIN_CAP (1u << 22)
__device__ __forceinline__ unsigned xb_ld(unsigned* p)              { return __hip_atomic_load(p, __ATOMIC_RELAXED, __HIP_MEMORY_SCOPE_AGENT); }
__device__ __forceinline__ unsigned xb_add(unsigned* p, unsigned v) { return __hip_atomic_fetch_add(p, v, __ATOMIC_RELAXED, __HIP_MEMORY_SCOPE_AGENT); }
__device__ __forceinline__ unsigned xb_xcc_id() { return (unsigned)__builtin_amdgcn_s_getreg((3 << 11) | 20) & 0xFu; }
#define XB_SPIN(cond, bar) do { unsigned _sp = 0; while (cond) { __builtin_amdgcn_s_sleep(1); \
    if ((++_sp & 255u) == 0u) { if (xb_ld(&(bar)[XB_TMO])) break; if (_sp > XB_SPIN_CAP) { atomicAdd(&(bar)[XB_TMO], 1u); break; } } } } while (0)
struct XcdBarrier { unsigned* bar; unsigned x; volatile LAS unsigned* st; };
__device__ __forceinline__ XcdBarrier xcd_barrier_post(unsigned* bar, volatile LAS unsigned* st) {
    XcdBarrier b; b.bar = bar; b.x = xb_xcc_id(); b.st = st;
    if (threadIdx.x == 0) (void)xb_add(&bar[XB_XCNT(b.x)], 1u);
    return b;
}
__device__ __forceinline__ void xcd_barrier_complete(unsigned* bar, unsigned x, unsigned& nloc, unsigned& nx) {
    const unsigned G = gridDim.x * gridDim.y * gridDim.z;
    unsigned sum, cnt, mine, sp = 0u;
    for (;;) {
        sum = 0u; cnt = 0u; mine = 0u;
#pragma unroll
        for (unsigned j = 0; j < 16; ++j) { const unsigned c = xb_ld(&bar[XB_XCNT(j)]); sum += c; cnt += (c > 0u) ? 1u : 0u; mine = (j == x) ? c : mine; }
        if (sum == G) break;
        __builtin_amdgcn_s_sleep(1);
        if ((++sp & 255u) == 0u) { if (xb_ld(&bar[XB_TMO])) break; if (sp > XB_SPIN_CAP) { atomicAdd(&bar[XB_TMO], 1u); break; } }
    }
    nloc = mine > 0u ? mine : 1u; nx = cnt > 0u ? cnt : 1u;
}
__device__ __forceinline__ void xcd_barrier(const XcdBarrier& b) {
    asm volatile("s_waitcnt vmcnt(0)" ::: "memory");
    __syncthreads();
    if (threadIdx.x == 0) {
        unsigned* bar = b.bar;
        __builtin_amdgcn_s_waitcnt(0);
        unsigned nloc = b.st[0], nx = b.st[1];
        if (nloc == 0u) { xcd_barrier_complete(bar, b.x, nloc, nx); b.st[0] = nloc; b.st[1] = nx; }
        const unsigned old = xb_add(&bar[XB_XSUB(b.x)], 1u);
        const unsigned gen = old / nloc;
        if (old + 1u == (gen + 1u) * nloc) {
            __builtin_amdgcn_fence(__ATOMIC_RELEASE, "agent");
            asm volatile("s_waitcnt vmcnt(0)" ::: "memory");
            const unsigned og = xb_add(&bar[XB_TOP], 1u);
            const unsigned tg = og / nx;
            if (og + 1u == (tg + 1u) * nx) xb_add(&bar[XB_TOPGEN], 1u);
            else XB_SPIN(xb_ld(&bar[XB_TOPGEN]) == tg, bar);
            __builtin_amdgcn_fence(__ATOMIC_ACQUIRE, "agent");
            xb_add(&bar[XB_XGEN(b.x)], 1u);
            asm volatile("s_waitcnt vmcnt(0)" ::: "memory");
        } else {
            XB_SPIN(xb_ld(&bar[XB_XGEN(b.x)]) == gen, bar);
            __builtin_amdgcn_fence(__ATOMIC_ACQUIRE, "agent");
            asm volatile("s_waitcnt vmcnt(0)" ::: "memory");
        }
    }
    __syncthreads();
}

struct Params { const float* in[22]; float* out; unsigned char* ws; int ph_lo, ph_hi; };

__device__ __forceinline__ void ssm_prep(LAS unsigned char* lds, const Params& p, int g) {
    const float* a_re = p.in[4]; const float* a_im = p.in[5]; const float* log_dt = p.in[6];
    const float* b_re = p.in[7]; const float* b_im = p.in[8]; const float* c_re = p.in[9]; const float* c_im = p.in[10]; const float* dskip = p.in[11];
    LAS float* apow = (LAS float*)lds;
    LAS float* Bb = apow + 2 * 17 * 64 * 2;
    LAS float* Cc = Bb + 2 * 64 * 16 * 2;
    LAS float* Kt = Cc + 2 * 16 * 64 * 2;
    const int tid = ltid();
    for (int idx = tid; idx < 2 * 17 * 64; idx += 512) {
        const int dir = idx / (17 * 64), j = (idx / 64) % 17, pp = idx % 64;
        const float are = a_re[(dir * 64 + g) * 64 + pp], aim = a_im[(dir * 64 + g) * 64 + pp], dt = expf(log_dt[dir * 64 + g]);
        const float x = are * dt * (float)j, y = aim * dt * (float)j; const float mag = expf(x); float s, c; sincosf(y, &s, &c);
        apow[idx * 2] = mag * c; apow[idx * 2 + 1] = mag * s;
    }
    for (int idx = tid; idx < 2 * 64 * 16; idx += 512) {
        const int dir = idx / 1024, pp = (idx / 16) % 64, c = idx % 16;
        const float are = a_re[(dir * 64 + g) * 64 + pp], aim = a_im[(dir * 64 + g) * 64 + pp], dt = expf(log_dt[dir * 64 + g]);
        const float x = are * dt, y = aim * dt; const float ex1 = expm1f(x); float sy, cy; sincosf(y, &sy, &cy); const float sh = sinf(0.5f * y);
        const float nr = ex1 * cy - 2.0f * sh * sh, ni = (ex1 + 1.0f) * sy;
        const float den = are * are + aim * aim; const float qr = (nr * are + ni * aim) / den, qi = (ni * are - nr * aim) / den;
        const float br = b_re[((dir * 64 + g) * 64 + pp) * 16 + c], bi = b_im[((dir * 64 + g) * 64 + pp) * 16 + c];
        Bb[idx * 2] = qr * br - qi * bi; Bb[idx * 2 + 1] = qr * bi + qi * br;
    }
    for (int idx = tid; idx < 2 * 16 * 64; idx += 512) {
        const int dir = idx / 1024, c = (idx / 64) % 16, pp = idx % 64;
        Cc[idx * 2] = c_re[((dir * 64 + g) * 16 + c) * 64 + pp]; Cc[idx * 2 + 1] = c_im[((dir * 64 + g) * 16 + c) * 64 + pp];
    }
    __syncthreads();
    for (int idx = tid; idx < 8192; idx += 512) {
        const int dir = idx >> 12, j = (idx >> 8) & 15, c = (idx >> 4) & 15, c2 = idx & 15;
        float acc = 0.f;
        for (int pp = 0; pp < 64; ++pp) {
            const float ar = apow[((dir * 17 + j) * 64 + pp) * 2], ai = apow[((dir * 17 + j) * 64 + pp) * 2 + 1];
            const float cr = Cc[((dir * 16 + c) * 64 + pp) * 2], ci = Cc[((dir * 16 + c) * 64 + pp) * 2 + 1];
            const float br = Bb[((dir * 64 + pp) * 16 + c2) * 2], bi = Bb[((dir * 64 + pp) * 16 + c2) * 2 + 1];
            const float wr = cr * ar - ci * ai, wi = cr * ai + ci * ar;
            acc += wr * br - wi * bi;
        }
        Kt[idx] = acc;
    }
    bf16_t* bty = (bf16_t*)((unsigned char*)p.out + DO_BTY) + (size_t)g * 256 * 512;
    bf16_t* bts = (bf16_t*)((unsigned char*)p.out + DO_BTS) + (size_t)g * 256 * 256;
    for (int idx = tid; idx < 65536; idx += 512) {
        const int n = idx >> 8, kk = idx & 255, t = n >> 4, c = n & 15, dir = kk >> 7, reim = (kk >> 6) & 1, pp = kk & 63;
        const int j = dir == 0 ? t + 1 : 16 - t;
        const float ar = apow[((dir * 17 + j) * 64 + pp) * 2], ai = apow[((dir * 17 + j) * 64 + pp) * 2 + 1];
        const float cr = Cc[((dir * 16 + c) * 64 + pp) * 2], ci = Cc[((dir * 16 + c) * 64 + pp) * 2 + 1];
        const float wr = cr * ar - ci * ai, wi = cr * ai + ci * ar;
        bty[n * 512 + 256 + kk] = f2bf(reim == 0 ? wr : -wi);
    }
    for (int idx = tid; idx < 65536; idx += 512) {
        const int n = idx >> 8, kk = idx & 255, dir = n >> 7, reim = (n >> 6) & 1, pp = n & 63, s = kk >> 4, c2 = kk & 15;
        const int j = dir == 0 ? 15 - s : s;
        const float ar = apow[((dir * 17 + j) * 64 + pp) * 2], ai = apow[((dir * 17 + j) * 64 + pp) * 2 + 1];
        const float br = Bb[((dir * 64 + pp) * 16 + c2) * 2], bi = Bb[((dir * 64 + pp) * 16 + c2) * 2 + 1];
        const float wr = ar * br - ai * bi, wi = ar * bi + ai * br;
        bts[n * 256 + kk] = f2bf(reim == 0 ? wr : wi);
    }
    __syncthreads();
    for (int idx = tid; idx < 65536; idx += 512) {
        const int n = idx >> 8, kk = idx & 255, t = n >> 4, c = n & 15, s = kk >> 4, c2 = kk & 15;
        float v = 0.f;
        if (s <= t) v += Kt[(((t - s)) * 16 + c) * 16 + c2];
        if (s >= t) v += Kt[((16 + (s - t)) * 16 + c) * 16 + c2];
        if (s == t && c == c2) v += dskip[g * 16 + c];
        bty[n * 512 + kk] = f2bf(v);
    }
    __syncthreads();
}

__device__ __forceinline__ int t5_bucket(int rel) {
    const int ret = rel > 0 ? 16 : 0; const int n = rel < 0 ? -rel : rel;
    if (n < 8) return ret + n;
    int large = 8 + (int)(logf((float)n / 8.0f) / 4.852030263919617f * 8.0f);
    large = large < 15 ? large : 15;
    return ret + large;
}

constexpr int RMS_NR = 4;
template <bool OUT_BF16>
__device__ __forceinline__ void rms_rows(const float* s0, const float* s1, const float* gam, void* dst, int G) {
    const int tid_ = ltid(); const int lane = tid_ & 63, gw = blockIdx.x * 8 + (tid_ >> 6), nw = G * 8;
    for (int r0 = gw; r0 < M_TOK; r0 += RMS_NR * nw) {
        f32x4 v[RMS_NR][8]; float ss[RMS_NR];
#pragma unroll
        for (int q = 0; q < RMS_NR; ++q) {
            const int r = r0 + q * nw, rc = r < M_TOK ? r : r0;
            const float* src = (s1 != nullptr && rc >= 32768) ? s1 + (size_t)(rc - 32768) * DM : s0 + (size_t)rc * DM;
#pragma unroll
            for (int j = 0; j < 8; ++j) v[q][j] = *(const f32x4*)(src + (j * 64 + lane) * 4);
        }
#pragma unroll
        for (int q = 0; q < RMS_NR; ++q) { float a = 0.f;
#pragma unroll
            for (int j = 0; j < 8; ++j) a += v[q][j][0] * v[q][j][0] + v[q][j][1] * v[q][j][1] + v[q][j][2] * v[q][j][2] + v[q][j][3] * v[q][j][3];
#pragma unroll
            for (int o = 32; o >= 1; o >>= 1) a += __shfl_xor(a, o);
            ss[q] = rsqrtf(a * (1.0f / DM) + 1e-6f); }
#pragma unroll
        for (int j = 0; j < 8; ++j) {
            const f32x4 gg = *(const f32x4*)(gam + (j * 64 + lane) * 4);
#pragma unroll
            for (int q = 0; q < RMS_NR; ++q) {
                const int r = r0 + q * nw; if (r >= M_TOK) continue;
                const f32x4 y = v[q][j] * ss[q] * gg;
                if constexpr (OUT_BF16) { u32x2 w; w.x = cvt_pk_bf16(y[0], y[1]); w.y = cvt_pk_bf16(y[2], y[3]); *(u32x2*)((bf16_t*)dst + (size_t)r * DM + (j * 64 + lane) * 4) = w; }
                else *(f32x4*)((float*)dst + (size_t)r * DM + (j * 64 + lane) * 4) = y;
            }
        }
    }
}

template <bool OUT_BF16>
__device__ __forceinline__ void rms_rows_b16(const bf16_t* src, const float* gam, void* dst, int G) {
    const int tid_ = ltid(); const int lane = tid_ & 63, gw = blockIdx.x * 8 + (tid_ >> 6), nw = G * 8;
    for (int r0 = gw; r0 < M_TOK; r0 += RMS_NR * nw) {
        u32x4 v[RMS_NR][4]; float ss[RMS_NR];
#pragma unroll
        for (int q = 0; q < RMS_NR; ++q) {
            const int r = r0 + q * nw, rc = r < M_TOK ? r : r0;
#pragma unroll
            for (int j = 0; j < 4; ++j) v[q][j] = *(const u32x4*)(src + (size_t)rc * DM + (j * 64 + lane) * 8);
        }
#pragma unroll
        for (int q = 0; q < RMS_NR; ++q) { float a = 0.f;
#pragma unroll
            for (int j = 0; j < 4; ++j) { f32x4 x0, x1; unpack8(v[q][j], x0, x1); a += (x0[0] * x0[0] + x0[1] * x0[1]) + (x0[2] * x0[2] + x0[3] * x0[3]) + (x1[0] * x1[0] + x1[1] * x1[1]) + (x1[2] * x1[2] + x1[3] * x1[3]); }
#pragma unroll
            for (int o = 32; o >= 1; o >>= 1) a += __shfl_xor(a, o);
            ss[q] = rsqrtf(a * (1.0f / DM) + 1e-6f); }
#pragma unroll
        for (int j = 0; j < 4; ++j) {
            const f32x4 g0 = *(const f32x4*)(gam + (j * 64 + lane) * 8), g1 = *(const f32x4*)(gam + (j * 64 + lane) * 8 + 4);
#pragma unroll
            for (int q = 0; q < RMS_NR; ++q) {
                const int r = r0 + q * nw; if (r >= M_TOK) continue;
                f32x4 x0, x1; unpack8(v[q][j], x0, x1);
                const f32x4 y0 = x0 * ss[q] * g0, y1 = x1 * ss[q] * g1;
                if constexpr (OUT_BF16) *(u32x4*)((bf16_t*)dst + (size_t)r * DM + (j * 64 + lane) * 8) = pack8(y0, y1);
                else { float* d = (float*)dst + (size_t)r * DM + (j * 64 + lane) * 8; *(f32x4*)d = y0; *(f32x4*)(d + 4) = y1; }
            }
        }
    }
}

__device__ __forceinline__ void prep_phase(LAS unsigned char* lds, const Params& p, int G) {
    const int tid = ltid();
    for (int g = blockIdx.x; g < 64; g += G) ssm_prep(lds, p, g);
    if ((int)blockIdx.x == G - 1) {
        float* bt = (float*)(p.ws + WS_BIAS); const float* rb = p.in[20];
        for (int idx = tid; idx < 12 * 129; idx += 512) { const int head = idx / 129, ri = idx % 129, d = 1 << (2 * (head >> 2));
            bt[head * 132 + ri] = rb[t5_bucket((ri - 64) * d) * 12 + head] * 1.4426950408889634f; }
    }
    {
        const float* srcs[7] = {p.in[3], p.in[12], p.in[14], p.in[15], p.in[16], p.in[18], p.in[19]};
        const size_t dofs[7] = {DO_WIN, DO_WGLU, DO_WBS, DO_WBA, DO_WOUT, DO_WFF1, DO_WFF2};
        const int Ks[7] = {2048, 1024, 1024, 512, 2048, 2048, 8192}, Ns[7] = {9728, 1024, 2048, 2048, 2048, 8192, 2048};
        LAS float* tl = (LAS float*)lds;
        int total = 0;
#pragma unroll
        for (int w = 0; w < 7; ++w) total += (Ks[w] / 64) * (Ns[w] / 64);
        const int tskew = G > 128 ? 64 : 0;
        for (int tile0 = (int)blockIdx.x - tskew; tile0 < total; tile0 += 2 * (G - tskew)) {
            if (tile0 < 0) break;
            float ld[2][8]; bf16_t* dsts[2]; int Kq[2], k0q[2], n0q[2]; bool okq[2];
#pragma unroll
            for (int q = 0; q < 2; ++q) {
                const int tile = tile0 + q * (G - tskew); okq[q] = tile < total;
                int w = 0, tt = okq[q] ? tile : tile0; const float* src = srcs[0]; size_t dof = dofs[0]; int K = Ks[0], N = Ns[0];
#pragma unroll
                for (int qq = 0; qq < 6; ++qq) { const int cnt = (Ks[qq] / 64) * (Ns[qq] / 64); if (w == qq && tt >= cnt) { tt -= cnt; w = qq + 1; src = srcs[qq + 1]; dof = dofs[qq + 1]; K = Ks[qq + 1]; N = Ns[qq + 1]; } }
                const int ntn = N / 64, k0 = (tt / ntn) * 64, n0 = (tt % ntn) * 64;
                dsts[q] = (bf16_t*)((unsigned char*)p.out + dof); Kq[q] = K; k0q[q] = k0; n0q[q] = n0;
                const int j = tid & 63, i0 = tid >> 6;
#pragma unroll
                for (int ii = 0; ii < 8; ++ii) { const int i = i0 + 8 * ii; ld[q][ii] = src[(size_t)(k0 + i) * N + n0 + j]; }
            }
#pragma unroll
            for (int q = 0; q < 2; ++q) { const int j = tid & 63, i0 = tid >> 6;
#pragma unroll
                for (int ii = 0; ii < 8; ++ii) { const int i = i0 + 8 * ii; tl[q * 64 * 65 + i * 65 + j] = ld[q][ii]; } }
            __syncthreads();
#pragma unroll
            for (int q = 0; q < 2; ++q) { if (!okq[q]) continue; const int kp = tid & 31, nn0 = tid >> 5;
#pragma unroll
                for (int jj = 0; jj < 4; ++jj) { const int nn = nn0 + 16 * jj;
                    *(unsigned*)(dsts[q] + (size_t)(n0q[q] + nn) * Kq[q] + k0q[q] + 2 * kp) = cvt_pk_bf16(tl[q * 64 * 65 + (2 * kp) * 65 + nn], tl[q * 64 * 65 + (2 * kp + 1) * 65 + nn]); } }
            __syncthreads();
        }
    }
    rms_rows<true>(p.in[0], p.in[1], p.in[2], (void*)((unsigned char*)p.out + DO_XN), G);
}

constexpr int VS_PITCH = 288, VS_ROWS = 208, VS_BYTES = VS_ROWS * VS_PITCH;
struct AttnItem { int head, dsh, r, pos0, seq_base, m, i0; };
__device__ __forceinline__ AttnItem attn_item(int it) {
    AttnItem a; a.head = it / 768; const int pb = it - a.head * 768, gi = a.head >> 2; a.dsh = gi * 2;
    const int p0 = pb * 64; int lsh; if (p0 < 32768) { a.seq_base = p0 & ~8191; lsh = 13; } else { a.seq_base = 32768; lsh = 14; }
    const int lm = lsh - a.dsh; a.m = 1 << lm; const int local = p0 - a.seq_base; a.r = local >> lm; a.i0 = local - (a.r << lm);
    a.pos0 = a.seq_base + (a.i0 << a.dsh); return a;
}
__device__ __forceinline__ int attn_pair(int j, int c, int G) {
    if ((G & 7) == 0 && (4608 % G) == 0) { const int per_xcd = 4608 / 8, wpx = G >> 3; return (c & 7) * per_xcd + j * wpx + (c >> 3); }
    return j * G + c;
}
__device__ __forceinline__ void attn_load_v(const AttnItem& a, const bf16_t* qkv, int ht, u32x4 (&vreg)[12]) {
#pragma unroll
    for (int pass = 0; pass < 12; ++pass) {
        const int row = pass * 16 + (ht >> 4), ch = ht & 15, ki = a.i0 - 64 + row;
        u32x4 val = (u32x4){0u, 0u, 0u, 0u};
        if (ki >= 0 && ki < a.m) val = *(const u32x4*)(qkv + ((size_t)(24 + a.head) * M_TOK + a.seq_base + a.r * a.m + ki) * 128 + ch * 8);
        vreg[pass] = val;
    }
}
template <bool EDGE>
__device__ __forceinline__ float attn_scores(f32x4 (&sa)[10], const LAS float* bsl, int dl, int kabs0, int m, float scale2) {
    float mx = -3.0e38f;
#pragma unroll
    for (int t9 = 0; t9 < 9; ++t9)
#pragma unroll
        for (int j = 0; j < 4; ++j) {
            bool valid = true;
            if (t9 == 0) valid = (j + dl >= 0);
            if (t9 == 8) valid = (j + dl <= 0);
            if (EDGE) { const int kabs = kabs0 + 16 * t9 + j; valid = valid && (kabs >= 0) && (kabs < m); }
            float sv = sa[t9][j] * scale2 + bsl[16 * t9 + j];
            sv = valid ? sv : -1.0e30f;
            sa[t9][j] = sv; mx = fmaxf(mx, sv);
        }
    return mx;
}
__device__ __forceinline__ void attn_phase(LAS unsigned char* lds, bf16_t* qkv, float* lse, const float* biasT, int G) {
    const int tid = ltid(), wave = __builtin_amdgcn_readfirstlane(tid >> 6), lane = tid & 63, half = wave >> 2, w4 = wave & 3, li = lane & 15, lg = lane >> 4, ht = tid & 255;
    LAS unsigned char* vs = lds + half * VS_BYTES;
    LAS float* bs = (LAS float*)(lds + 2 * VS_BYTES + half * 1024);
    const float scale2 = 0.08838834764831845f * 1.4426950408889634f;
    for (int i = ht; i < 16 * VS_PITCH / 16; i += 256) *(LAS u32x4*)(vs + 192 * VS_PITCH + i * 16) = (u32x4){0u, 0u, 0u, 0u};
    if (ht < 176) bs[ht] = 0.f;
    const int dl = 4 * lg - li, q4 = li >> 2, p4 = li & 3;
    const LAS float* bsl = bs + 16 + dl;
    const LAS unsigned char* vrd = vs + (16 * w4 + 4 * lg + q4) * VS_PITCH + (4 * p4) * 2;
    u32x4 vreg[12];
    const int nrounds = (4608 + G - 1) / G, cwg = blockIdx.x;
    { const int pair0 = attn_pair(0, cwg, G); if (pair0 < 4608) { const AttnItem a = attn_item(pair0 * 2 + half); attn_load_v(a, qkv, ht, vreg); } }
    __syncthreads();
    for (int j = 0; j < nrounds; ++j) {
        const int pair = attn_pair(j, cwg, G); if (pair >= 4608) break;
        const int pairn = (j + 1 < nrounds) ? attn_pair(j + 1, cwg, G) : 4608;
        const AttnItem a = attn_item(pair * 2 + half);
#pragma unroll
        for (int pass = 0; pass < 12; ++pass) *(LAS u32x4*)(vs + (pass * 16 + (ht >> 4)) * VS_PITCH + (ht & 15) * 16) = vreg[pass];
        if (ht < 129) bs[16 + ht] = biasT[a.head * 132 + ht];
        __syncthreads();
        const size_t tokq = (size_t)(a.pos0 + a.r + ((16 * w4 + li) << a.dsh));
        const int pbase = a.seq_base + a.r * a.m;
        bf16_t* qp = qkv + ((size_t)a.head * M_TOK + pbase + a.i0 + 16 * w4 + li) * 128;
        bf16x8 Qf[4];
#pragma unroll
        for (int ks = 0; ks < 4; ++ks) Qf[ks] = *(const bf16x8*)(qp + 32 * ks + 8 * lg);
        const int kbase = a.i0 - 64 + 16 * w4 + li;
        const bf16_t* kcol = qkv + ((size_t)(12 + a.head) * M_TOK + pbase) * 128 + 8 * lg;
        f32x4 sa[10];
        bf16x8 Kf[2][3][4];
#define ATT_LOADK(buf, grp) do { _Pragma("unroll") for (int tt = 0; tt < 3; ++tt) { int ki = kbase + 16 * ((grp) * 3 + tt); ki = ki < 0 ? 0 : (ki > a.m - 1 ? a.m - 1 : ki); \
            const bf16_t* kp = kcol + (size_t)ki * 128; \
            _Pragma("unroll") for (int ks = 0; ks < 4; ++ks) Kf[buf][tt][ks] = *(const bf16x8*)(kp + 32 * ks); } } while (0)
#define ATT_MMAK(buf, grp) do { _Pragma("unroll") for (int tt = 0; tt < 3; ++tt) { f32x4 acc_ = (f32x4){0.f, 0.f, 0.f, 0.f}; \
            _Pragma("unroll") for (int ks = 0; ks < 4; ++ks) acc_ = __builtin_amdgcn_mfma_f32_16x16x32_bf16(Kf[buf][tt][ks], Qf[ks], acc_, 0, 0, 0); sa[(grp) * 3 + tt] = acc_; } } while (0)
        ATT_LOADK(0, 0); ATT_LOADK(1, 1);
        __builtin_amdgcn_sched_barrier(0);
        ATT_MMAK(0, 0);
        __builtin_amdgcn_sched_barrier(0);
        ATT_LOADK(0, 2);
        if (pairn < 4608) { const AttnItem an = attn_item(pairn * 2 + half); attn_load_v(an, qkv, ht, vreg); }
        __builtin_amdgcn_sched_barrier(0);
        ATT_MMAK(1, 1);
        ATT_MMAK(0, 2);
#undef ATT_LOADK
#undef ATT_MMAK
        sa[9] = (f32x4){0.f, 0.f, 0.f, 0.f};
        const int kabs0 = a.i0 - 64 + 16 * w4 + 4 * lg;
        const bool edge = (a.i0 == 0) || (a.i0 + 64 == a.m);
        float mx = edge ? attn_scores<true>(sa, bsl, dl, kabs0, a.m, scale2) : attn_scores<false>(sa, bsl, dl, kabs0, a.m, scale2);
        mx = fmaxf(mx, __shfl_xor(mx, 16)); mx = fmaxf(mx, __shfl_xor(mx, 32));
        float sum = 0.f;
#pragma unroll
        for (int t9 = 0; t9 < 9; ++t9)
#pragma unroll
            for (int j = 0; j < 4; ++j) { const float pv = __builtin_amdgcn_exp2f(sa[t9][j] - mx); sa[t9][j] = pv; sum += pv; }
        sum += __shfl_xor(sum, 16); sum += __shfl_xor(sum, 32);
        bf16x8 Pf[5];
#pragma unroll
        for (int s5 = 0; s5 < 5; ++s5) {
            u32x4 w; w.x = cvt_pk_bf16(sa[2 * s5][0], sa[2 * s5][1]); w.y = cvt_pk_bf16(sa[2 * s5][2], sa[2 * s5][3]);
            w.z = cvt_pk_bf16(sa[2 * s5 + 1][0], sa[2 * s5 + 1][1]); w.w = cvt_pk_bf16(sa[2 * s5 + 1][2], sa[2 * s5 + 1][3]);
            Pf[s5] = __builtin_bit_cast(bf16x8, w);
        }
        const float inv = 1.0f / sum;
        f32x4 o[8];
#pragma unroll
        for (int dt = 0; dt < 8; ++dt) o[dt] = (f32x4){0.f, 0.f, 0.f, 0.f};
#pragma unroll
        for (int s5 = 0; s5 < 5; ++s5) {
            s16x4 va[8], vb[8];
#pragma unroll
            for (int dt = 0; dt < 8; ++dt) {
                va[dt] = __builtin_amdgcn_ds_read_tr16_b64_v4i16((LAS s16x4*)(vrd + (32 * s5) * VS_PITCH + 32 * dt));
                vb[dt] = __builtin_amdgcn_ds_read_tr16_b64_v4i16((LAS s16x4*)(vrd + (32 * s5 + 16) * VS_PITCH + 32 * dt));
            }
#pragma unroll
            for (int dt = 0; dt < 8; ++dt) {
                const bf16x8 Vf = (bf16x8){va[dt][0], va[dt][1], va[dt][2], va[dt][3], vb[dt][0], vb[dt][1], vb[dt][2], vb[dt][3]};
                o[dt] = __builtin_amdgcn_mfma_f32_16x16x32_bf16(Vf, Pf[s5], o[dt], 0, 0, 0);
            }
        }
#pragma unroll
        for (int dt = 0; dt < 8; ++dt) {
            const f32x4 ov = o[dt] * inv;
            u32x2 w; w.x = cvt_pk_bf16(ov[0], ov[1]); w.y = cvt_pk_bf16(ov[2], ov[3]);
            *(u32x2*)(qp + 16 * dt + 4 * lg) = w;
        }
        if (lg == 0) lse[tokq * 12 + a.head] = (mx + __log2f(sum)) * 0.6931471805599453f;
        __syncthreads();
    }
}

__device__ __forceinline__ void scan_merge_phase(const Params& p, int G) {
    const int tid = ltid(), lane = tid & 63;
    const bf16_t* S = (const bf16_t*)((unsigned char*)p.out + DO_XN);
    bf16_t* assm = (bf16_t*)(p.ws + WS_ASSM);
    for (int item = (tid >> 6) * G + blockIdx.x; item < 640; item += 8 * G) {
        const int g = item & 63, dir = (item >> 6) & 1, seq = item >> 7;
        const int n0 = seq < 4 ? seq * 512 : 2048, len = seq < 4 ? 512 : 1024;
        const float are = p.in[4][(dir * 64 + g) * 64 + lane], aim = p.in[5][(dir * 64 + g) * 64 + lane], dt = expf(p.in[6][dir * 64 + g]);
        const float mag = expf(16.0f * are * dt); float sn, cs; sincosf(16.0f * aim * dt, &sn, &cs);
        const float ar = mag * cs, ai = mag * sn;
        float hr = 0.f, hi = 0.f;
        const int nstart = dir == 0 ? n0 : n0 + len - 1; const long step = dir == 0 ? 1 : -1;
        const bf16_t* Sp = S + ((size_t)g * NCHUNK + nstart) * 256 + dir * 128 + lane;
        bf16_t* Ap = assm + ((size_t)g * NCHUNK + nstart) * 512 + 256 + dir * 128 + lane;
        const long sS = step * 256, sA = step * 512;
        float sr[2][16], si[2][16];
#define SCAN_LOAD(buf, b) do { _Pragma("unroll") for (int k = 0; k < 16; ++k) { sr[buf][k] = __uint_as_float((unsigned)Sp[((b) + k) * sS] << 16); si[buf][k] = __uint_as_float((unsigned)Sp[((b) + k) * sS + 64] << 16); } } while (0)
#define SCAN_STEP(buf, b) do { _Pragma("unroll") for (int k = 0; k < 16; ++k) { Ap[((b) + k) * sA] = f2bf(hr); Ap[((b) + k) * sA + 64] = f2bf(hi); \
            const float nr = ar * hr - ai * hi + sr[buf][k], ni = ar * hi + ai * hr + si[buf][k]; hr = nr; hi = ni; } } while (0)
        SCAN_LOAD(0, 0);
        for (int b = 0; b < len; b += 32) {
            SCAN_LOAD(1, b + 16);
            SCAN_STEP(0, b);
            if (b + 32 < len) SCAN_LOAD(0, b + 32);
            SCAN_STEP(1, b + 16);
        }
#undef SCAN_LOAD
#undef SCAN_STEP
    }
    const bf16_t* o = (const bf16_t*)(p.ws + WS_QKV); const float* lse = (const float*)(p.ws + WS_LSE);
    bf16_t* ya = (bf16_t*)((unsigned char*)p.out + DO_YATT);
    for (int idx0 = blockIdx.x * 512 + tid; idx0 < M_TOK * 64; idx0 += 2 * G * 512) {
        f32x4 a0[2], a1[2], b0[2], b1[2], c0[2], c1[2]; float w0[2], w1[2], w2[2];
#pragma unroll
        for (int q = 0; q < 2; ++q) {
            const int idx = idx0 + q * G * 512 < M_TOK * 64 ? idx0 + q * G * 512 : idx0;
            const int tok = idx >> 6, hh = (idx >> 4) & 3, ch = idx & 15;
            const float l0 = lse[tok * 12 + hh], l1 = lse[tok * 12 + 4 + hh], l2 = lse[tok * 12 + 8 + hh];
            int sbase, lsh; if (tok < 32768) { sbase = tok & ~8191; lsh = 13; } else { sbase = 32768; lsh = 14; }
            const int local = tok - sbase;
            const int p1 = sbase + ((local & 3) << (lsh - 2)) + (local >> 2), p2 = sbase + ((local & 15) << (lsh - 4)) + (local >> 4);
            unpack8(*(const u32x4*)(o + ((size_t)hh * M_TOK + tok) * 128 + ch * 8), a0[q], a1[q]);
            unpack8(*(const u32x4*)(o + ((size_t)(4 + hh) * M_TOK + p1) * 128 + ch * 8), b0[q], b1[q]);
            unpack8(*(const u32x4*)(o + ((size_t)(8 + hh) * M_TOK + p2) * 128 + ch * 8), c0[q], c1[q]);
            const float mx = fmaxf(l0, fmaxf(l1, l2)); w0[q] = __expf(l0 - mx); w1[q] = __expf(l1 - mx); w2[q] = __expf(l2 - mx);
            const float inv = 1.0f / (w0[q] + w1[q] + w2[q]); w0[q] *= inv; w1[q] *= inv; w2[q] *= inv;
        }
#pragma unroll
        for (int q = 0; q < 2; ++q) {
            const int idx = idx0 + q * G * 512; if (idx >= M_TOK * 64) continue;
            const int tok = idx >> 6, hh = (idx >> 4) & 3, ch = idx & 15;
            *(u32x4*)(ya + (size_t)tok * 512 + hh * 128 + ch * 8) = pack8(a0[q] * w0[q] + b0[q] * w1[q] + c0[q] * w2[q], a1[q] * w0[q] + b1[q] * w1[q] + c1[q] * w2[q]);
        }
    }
}

template <bool COOP>
__global__ void __launch_bounds__(512, 2) fwd_kernel(Params p) {
    extern __shared__ __attribute__((aligned(16))) unsigned char lds_raw[];
    LAS unsigned char* lds = (LAS unsigned char*)lds_raw;
    const int G = gridDim.x;
    XcdBarrier xb; xb.bar = (unsigned*)(p.ws + WS_BAR); xb.x = 0; xb.st = (volatile LAS unsigned*)(lds + 131072);
    bool posted = false;
    if constexpr (COOP) {
        if (threadIdx.x < 4) ((LAS unsigned*)(lds + 131072))[threadIdx.x] = 0u;
        if (blockIdx.x == 0) for (int i = threadIdx.x; i < XCD_BAR_WORDS; i += 512) __hip_atomic_store(xb.bar + i, 0u, __ATOMIC_RELAXED, __HIP_MEMORY_SCOPE_AGENT);
        __syncthreads();
    }
    for (int ph = p.ph_lo; ph < p.ph_hi; ++ph)
    for (int rep = 0; rep < (((PROBE_MASK >> ph) & 1u) ? 2 : 1); ++rep) {
        if ((ph > p.ph_lo || rep > 0) && !(COOP && ph == 7)) { if constexpr (COOP) {
            if (USE_CG_ALL) cg::this_grid().sync();
            else if (!posted) { cg::this_grid().sync(); xb = xcd_barrier_post((unsigned*)(p.ws + WS_BAR), (volatile LAS unsigned*)(lds + 131072)); posted = true; }
            else xcd_barrier(xb);
        } }
        unsigned char* ws = lptr(p.ws); unsigned char* dob = lptr((unsigned char*)p.out);
        const bf16_t* hb16 = (const bf16_t*)(ws + WS_GATES); const bf16_t* hfin16 = hb16 + (size_t)M_TOK * DM;
        if (ph == 0) { prep_phase(lds, p, G); continue; }
        if (ph == 3) { scan_merge_phase(p, G); continue; }
        if (ph == 9) { rms_rows_b16<true>(hb16, p.in[17], (void*)(dob + DO_XN), G); continue; }
        if (ph == N_PHASES - 1) { rms_rows_b16<false>(hfin16, p.in[21], (void*)p.out, G); continue; }
        bf16_t* assm = (bf16_t*)(ws + WS_ASSM); bf16_t* z = (bf16_t*)(dob + DO_XN);
        pg8::GemmD g; pg8::Sched S; pg8::Epi E;
        E.ws = ws; E.dob = dob; E.bglu = p.in[13]; E.x0 = p.in[0]; E.x1 = p.in[1]; E.hoff = 0;
        S.G = G; S.c = blockIdx.x; S.ssm = 0; S.nM = M_TOK / 256;
        if (ph == 1) { g = {z, (const bf16_t*)(dob + DO_WIN), DM, DM, DM}; S.nN = 38; E.mode = pg8::EM_INPROJ; }
        else if (ph == 2) { g = {assm, (const bf16_t*)(dob + DO_BTS), 512, 256, 256}; S.ssm = 1; S.nM = 768; S.nN = 1; E.mode = pg8::EM_SSM_S; }
        else if (ph == 4) { g = {assm, (const bf16_t*)(dob + DO_BTY), 512, 512, 512}; S.ssm = 1; S.nM = 768; S.nN = 1; E.mode = pg8::EM_SSM_Y; }
        else if (ph == 5) { g = {z, (const bf16_t*)(dob + DO_WGLU), SSMW, SSMW, SSMW}; S.nN = 4; E.mode = pg8::EM_GLU; }
        else if (ph == 6) { g = {z + (size_t)M_TOK * SSMW, (const bf16_t*)(dob + DO_WBS), SSMW, SSMW, SSMW}; S.nN = 8; E.mode = pg8::EM_BR1; }
        else if (ph == 7) { g = {(const bf16_t*)(dob + DO_YATT), (const bf16_t*)(dob + DO_WBA), 512, 512, 512}; S.nN = 8; E.mode = pg8::EM_BR2; }
        else if (ph == 8) { g = {(const bf16_t*)(ws + WS_QKV), (const bf16_t*)(dob + DO_WOUT), DM, DM, DM}; S.nN = 8; E.mode = pg8::EM_OUT; }
        else {
            const int c = (ph - 10) >> 1;
            if (((ph - 10) & 1) == 0) { g = {z + (size_t)c * FF_ROWS * DM, (const bf16_t*)(dob + DO_WFF1), DM, DM, DM}; S.nM = FF_ROWS / 256; S.nN = 32; E.mode = pg8::EM_FF1; }
            else { g = {(const bf16_t*)(ws + WS_QKV), (const bf16_t*)(dob + DO_WFF2), DFF, DFF, DFF}; S.nM = FF_ROWS / 256; S.nN = 8; E.mode = pg8::EM_FF2; E.hoff = (size_t)c * FF_ROWS * DM; }
        }
        S.nwg = S.nM * S.nN;
        pg8::gemm_phase(lds, g, S, E);
        if (ph == 2) attn_phase(lds, (bf16_t*)(ws + WS_QKV), (float*)(ws + WS_LSE), (const float*)(ws + WS_BIAS), G);
    }
}

extern "C" void kernel_launch(void* const* d_in, const int* in_sizes, int n_in, void* d_out, int out_size, void* d_ws, size_t ws_size, hipStream_t stream) {
    static int grid = 0;
    if (grid == 0) {
        if (n_in != 22 || out_size != M_TOK * DM || ws_size < WS_END) { fprintf(stderr, "kernel_launch: unexpected shapes (n_in %d, out %d, ws %zu, need %zu)\n", n_in, out_size, ws_size, (size_t)WS_END); grid = -1; return; }
        int dev = 0, cus = 0, per_cu = 0;
        (void)hipGetDevice(&dev); (void)hipDeviceGetAttribute(&cus, hipDeviceAttributeMultiprocessorCount, dev);
        (void)hipFuncSetAttribute((const void*)fwd_kernel<true>, hipFuncAttributeMaxDynamicSharedMemorySize, LDS_BYTES);
        (void)hipFuncSetAttribute((const void*)fwd_kernel<false>, hipFuncAttributeMaxDynamicSharedMemorySize, LDS_BYTES);
        (void)hipOccupancyMaxActiveBlocksPerMultiprocessor(&per_cu, (const void*)fwd_kernel<true>, 512, LDS_BYTES);
        if (per_cu < 1) per_cu = 1;
        (void)hipGetLastError();
        grid = cus * per_cu; if (grid > 256) grid = 256; if (grid < 1) grid = 256;
    }
    if (grid < 0) return;
    Params p{};
    for (int i = 0; i < 22; ++i) p.in[i] = (const float*)d_in[i];
    p.out = (float*)d_out; p.ws = (unsigned char*)d_ws;
#if MK_COOP
    p.ph_lo = 0; p.ph_hi = N_PHASES;
    void* args[] = {&p};
    hipError_t e = hipLaunchCooperativeKernel((const void*)fwd_kernel<true>, dim3(grid), dim3(512), args, LDS_BYTES, stream);
    if (e != hipSuccess) fprintf(stderr, "cooperative launch failed: %s (grid %d)\n", hipGetErrorString(e), grid);
#else
    for (int ph = 0; ph < N_PHASES; ++ph) {
        p.ph_lo = ph; p.ph_hi = ph + 1;
        hipLaunchKernelGGL(fwd_kernel<false>, dim3(grid), dim3(512), LDS_BYTES, stream, p);
    }
#endif
}
```

```cpp
#include <hip/hip_runtime.h>
#include <hip/hip_cooperative_groups.h>
#include <cstdio>
#include <cstdint>
namespace cg = cooperative_groups;

#ifndef MK_COOP
#define MK_COOP 1
#endif

#ifndef BAR_MODE
#define BAR_MODE 2
#endif
#ifndef PROBE_MASK
#define PROBE_MASK 0u
#endif
#define LAS __attribute__((address_space(3)))
typedef unsigned short bf16_t;
typedef short bf16x8 __attribute__((ext_vector_type(8)));
typedef short s16x4 __attribute__((ext_vector_type(4)));
typedef float f32x4 __attribute__((ext_vector_type(4)));
typedef unsigned u32x4 __attribute__((ext_vector_type(4)));
typedef unsigned u32x2 __attribute__((ext_vector_type(2)));

constexpr int M_TOK = 49152, DM = 2048, SSMW = 1024, QKVW = 4608, GATEW = 4096, DFF = 8192;
constexpr int NCHUNK = M_TOK / 16;
constexpr int FF_ROWS = 24576, N_FFC = 2;
constexpr int N_PHASES = 10 + 2 * N_FFC + 1;
constexpr int LDS_BYTES = 131072 + 16;

constexpr size_t WS_ASSM = 0;
constexpr size_t WS_QKV = 201326592;
constexpr size_t WS_GATES = WS_QKV + 452984832;
constexpr size_t WS_LSE = WS_GATES + 402653184;
constexpr size_t WS_BIAS = WS_LSE + 2359296;
constexpr size_t WS_BAR = WS_BIAS + 8192;
constexpr size_t WS_END = WS_BAR + 16384;
constexpr size_t DO_WIN = 0, DO_WGLU = 39845888, DO_WBS = 41943040, DO_WBA = 46137344, DO_WOUT = 48234496, DO_WFF1 = 56623104, DO_WFF2 = 90177536;
constexpr size_t DO_BTY = 123731968;
constexpr size_t DO_BTS = 140509184;
constexpr size_t DO_XN = 148897792;
constexpr size_t DO_YATT = 350224384;

__device__ __forceinline__ unsigned cvt_pk_bf16(float lo, float hi) { unsigned r; asm("v_cvt_pk_bf16_f32 %0, %1, %2" : "=v"(r) : "v"(lo), "v"(hi)); return r; }
__device__ __forceinline__ bf16_t f2bf(float f) { unsigned u = __float_as_uint(f); u += 0x7FFFu + ((u >> 16) & 1u); return (bf16_t)(u >> 16); }
__device__ __forceinline__ float bflo(unsigned w) { return __uint_as_float(w << 16); }
__device__ __forceinline__ float bfhi(unsigned w) { return __uint_as_float(w & 0xffff0000u); }
__device__ __forceinline__ void unpack8(const u32x4 w, f32x4& a, f32x4& b) { a = (f32x4){bflo(w.x), bfhi(w.x), bflo(w.y), bfhi(w.y)}; b = (f32x4){bflo(w.z), bfhi(w.z), bflo(w.w), bfhi(w.w)}; }
__device__ __forceinline__ u32x4 pack8(const f32x4 a, const f32x4 b) { u32x4 w; w.x = cvt_pk_bf16(a[0], a[1]); w.y = cvt_pk_bf16(a[2], a[3]); w.z = cvt_pk_bf16(b[0], b[1]); w.w = cvt_pk_bf16(b[2], b[3]); return w; }
__device__ __forceinline__ float sigmoidf_(float x) { return 1.0f / (1.0f + __expf(-x)); }
__device__ __forceinline__ float gelu_tanh(float x) { const float y = 0.7978845608028654f * (x + 0.044715f * x * x * x); return x / (1.0f + __expf(-2.0f * y)); }

__device__ __forceinline__ int ltid() { int t = threadIdx.x; asm volatile("" : "+v"(t)); return t; }
__device__ __forceinline__ size_t opaque_zero() { size_t z = 0; asm volatile("" : "+s"(z)); return z; }
template <class T> __device__ __forceinline__ T* lptr(T* p) { return (T*)((unsigned char*)p + opaque_zero()); }
namespace pg8 {
constexpr int BM = 256, BK = 64, HALF = 128, HTB = HALF * BK * 2, NXCD = 8, WGM = 4;
__device__ __forceinline__ int lds_byte(int r, int c) { const int st = (r >> 4) * 2 + (c >> 5), rr = r & 15, cc = c & 31, ob = rr * 64 + cc * 2; return st * 1024 + (ob ^ (((ob >> 9) & 1) << 5)); }
__device__ __forceinline__ void stage_rc(int b, int& R, int& C) { const int st = b / 1024, sb = b % 1024, swz = sb ^ (((sb >> 9) & 1) << 5); R = (st >> 1) * 16 + swz / 64; C = (st & 1) * 32 + (swz % 64) / 2; }
__device__ __forceinline__ int perm32(int rho) { const int n = rho >> 4, i = rho & 15; return 8 * (i >> 2) + 4 * n + (i & 3); }

struct Unit { int pm, pn; };
struct GemmD { const bf16_t* A; const bf16_t* Bt; int lda, ldb, K; };

struct Sched {
    int nM, nN, nwg, G, c, ssm;
    __device__ __forceinline__ bool next(int i, Unit& u) const {
        const long L = (long)i * G + c; if (L >= nwg) return false;
        if (ssm) { u.pm = (int)L; u.pn = (int)L / 12; return true; }
        int wgid = (int)L; { const int q = nwg / NXCD, r = nwg % NXCD, xcd = wgid % NXCD, off = wgid / NXCD; wgid = (xcd < r ? xcd * (q + 1) : r * (q + 1) + (xcd - r) * q) + off; }
        const int nig = WGM * nN, gid = wgid / nig, fm = gid * WGM, gsz = (nM - fm) < WGM ? (nM - fm) : WGM;
        u.pm = fm + ((wgid % nig) % gsz); u.pn = (wgid % nig) / gsz; return true;
    }
};

enum { EM_INPROJ = 0, EM_SSM_S, EM_SSM_Y, EM_GLU, EM_BR1, EM_BR2, EM_OUT, EM_FF1, EM_FF2 };
struct Epi {
    int mode; unsigned char* ws; unsigned char* dob; const float* bglu; const float* x0; const float* x1; size_t hoff;
};
struct EpiP { bf16_t* assm; bf16_t* qkv; bf16_t* gates; bf16_t* S; bf16_t* z; const float* bglu; bf16_t* yssm; bf16_t* mixed; const float* x0; const float* x1; bf16_t* hb; bf16_t* hfin; bf16_t* act; };

template <int MODE>
__device__ __forceinline__ void epi_body(const Epi& E0, const f32x4 (&acc)[2][2][4][2], const Unit& u, int wr, int wc, int fr, int fq) {
    asm volatile("" : "+v"(fr), "+v"(fq));
    unsigned char* ws = lptr(E0.ws); unsigned char* dob = lptr(E0.dob);
    EpiP E;
    E.assm = (bf16_t*)(ws + WS_ASSM); E.qkv = (bf16_t*)(ws + WS_QKV); E.gates = (bf16_t*)(ws + WS_GATES); E.S = (bf16_t*)(dob + DO_XN); E.z = (bf16_t*)(dob + DO_XN);
    E.bglu = E0.bglu; E.yssm = E.z + (size_t)M_TOK * SSMW; E.mixed = (bf16_t*)(ws + WS_QKV); E.x0 = E0.x0; E.x1 = E0.x1; E.hb = (bf16_t*)(ws + WS_GATES) + E0.hoff; E.hfin = (bf16_t*)(ws + WS_GATES) + (size_t)M_TOK * DM + E0.hoff; E.act = (bf16_t*)(ws + WS_QKV);
    const int row0 = u.pm * BM + wr * 64 + fr, cl0 = wc * 32 + 8 * fq;
#pragma unroll
    for (int ai = 0; ai < 2; ++ai)
#pragma unroll
        for (int m = 0; m < 4; ++m) {
            const int r = row0 + ai * HALF + m * 16;
#pragma unroll
            for (int bj = 0; bj < 2; ++bj) {
                const int cl = cl0 + bj * HALF;
                f32x4 v0 = acc[ai][bj][m][0], v1 = acc[ai][bj][m][1];
                if constexpr (MODE == EM_INPROJ) {
                    if (u.pn < 4) {
                        const int col = u.pn * 256 + cl, g = col >> 4, cc = col & 15, chunk = r >> 4, t = r & 15;
                        *(u32x4*)(E.assm + ((size_t)(g * NCHUNK + chunk) * 512 + t * 16 + cc)) = pack8(v0, v1);
                    } else if (u.pn < 22) {
                        const int hidx = (u.pn - 4) * 2 + bj, tensor = hidx / 12, head = hidx - tensor * 12, dcol = cl & 127, dsh = (head >> 2) * 2;
                        int sbase, lsh; if (r < 32768) { sbase = r & ~8191; lsh = 13; } else { sbase = 32768; lsh = 14; }
                        const int local = r - sbase, perm = sbase + ((local & ((1 << dsh) - 1)) << (lsh - dsh)) + (local >> dsh);
                        *(u32x4*)(E.qkv + ((size_t)hidx * M_TOK + perm) * 128 + dcol) = pack8(v0, v1);
                    } else {
#pragma unroll
                        for (int j = 0; j < 4; ++j) { v0[j] = sigmoidf_(v0[j]); v1[j] = sigmoidf_(v1[j]); }
                        *(u32x4*)(E.gates + (size_t)r * GATEW + (u.pn - 22) * 256 + cl) = pack8(v0, v1);
                    }
                } else if constexpr (MODE == EM_SSM_S) {
                    *(u32x4*)(E.S + (size_t)r * 256 + cl) = pack8(v0, v1);
                } else if constexpr (MODE == EM_SSM_Y) {
                    const int g = u.pm / 12, chunk = r - g * NCHUNK, t = cl >> 4, cc = cl & 15, tok = chunk * 16 + t;
#pragma unroll
                    for (int j = 0; j < 4; ++j) { v0[j] = gelu_tanh(v0[j]); v1[j] = gelu_tanh(v1[j]); }
                    *(u32x4*)(E.z + (size_t)tok * SSMW + g * 16 + cc) = pack8(v0, v1);
                } else if constexpr (MODE == EM_GLU) {
                    const int c = u.pn * 256 + cl; const size_t off = (size_t)r * SSMW + c;
                    f32x4 z0, z1; unpack8(*(const u32x4*)(E.z + off), z0, z1);
                    const f32x4 b0 = *(const f32x4*)(E.bglu + c), b1 = *(const f32x4*)(E.bglu + c + 4);
#pragma unroll
                    for (int j = 0; j < 4; ++j) { v0[j] = z0[j] * sigmoidf_(v0[j] + b0[j]); v1[j] = z1[j] * sigmoidf_(v1[j] + b1[j]); }
                    *(u32x4*)(E.yssm + off) = pack8(v0, v1);
                } else if constexpr (MODE == EM_BR1) {
                    const int c = u.pn * 256 + cl;
                    f32x4 g0, g1; unpack8(*(const u32x4*)(E.gates + (size_t)r * GATEW + c), g0, g1);
                    *(u32x4*)(E.mixed + (size_t)r * DM + c) = pack8(g0 * v0, g1 * v1);
                } else if constexpr (MODE == EM_BR2) {
                    const int c = u.pn * 256 + cl;
                    f32x4 g0, g1, m0, m1; unpack8(*(const u32x4*)(E.gates + (size_t)r * GATEW + DM + c), g0, g1);
                    bf16_t* mp = E.mixed + (size_t)r * DM + c; unpack8(*(const u32x4*)mp, m0, m1);
                    *(u32x4*)mp = pack8(m0 + g0 * v0, m1 + g1 * v1);
                } else if constexpr (MODE == EM_OUT) {
                    const int c = u.pn * 256 + cl;
                    const float* xr = (r < 32768 ? E.x0 + (size_t)r * DM : E.x1 + (size_t)(r - 32768) * DM) + c;
                    *(u32x4*)(E.hb + (size_t)r * DM + c) = pack8(*(const f32x4*)xr + v0, *(const f32x4*)(xr + 4) + v1);
                } else if constexpr (MODE == EM_FF1) {
                    const int c = u.pn * 256 + cl;
#pragma unroll
                    for (int j = 0; j < 4; ++j) { const float a = fmaxf(v0[j], 0.f), b = fmaxf(v1[j], 0.f); v0[j] = a * a; v1[j] = b * b; }
                    *(u32x4*)(E.act + (size_t)r * DFF + c) = pack8(v0, v1);
                } else if constexpr (MODE == EM_FF2) {
                    const int c = u.pn * 256 + cl;
                    f32x4 h0, h1; unpack8(*(const u32x4*)(E.hb + (size_t)r * DM + c), h0, h1);
                    *(u32x4*)(E.hfin + (size_t)r * DM + c) = pack8(h0 + v0, h1 + v1);
                }
            }
        }
}
__device__ __forceinline__ void epi_run(const Epi& E, const f32x4 (&acc)[2][2][4][2], const Unit& u, int wr, int wc, int fr, int fq) {
    switch (E.mode) {
        case EM_INPROJ: epi_body<EM_INPROJ>(E, acc, u, wr, wc, fr, fq); break;
        case EM_SSM_S: epi_body<EM_SSM_S>(E, acc, u, wr, wc, fr, fq); break;
        case EM_SSM_Y: epi_body<EM_SSM_Y>(E, acc, u, wr, wc, fr, fq); break;
        case EM_GLU: epi_body<EM_GLU>(E, acc, u, wr, wc, fr, fq); break;
        case EM_BR1: epi_body<EM_BR1>(E, acc, u, wr, wc, fr, fq); break;
        case EM_BR2: epi_body<EM_BR2>(E, acc, u, wr, wc, fr, fq); break;
        case EM_OUT: epi_body<EM_OUT>(E, acc, u, wr, wc, fr, fq); break;
        case EM_FF1: epi_body<EM_FF1>(E, acc, u, wr, wc, fr, fq); break;
        default: epi_body<EM_FF2>(E, acc, u, wr, wc, fr, fq); break;
    }
}

__device__ __forceinline__ void gemm_phase(LAS unsigned char* lds, const GemmD g, const Sched& S, const Epi& E) {
    const int tid = ltid(), wid = __builtin_amdgcn_readfirstlane(tid >> 6), lane = tid & 63, wr = wid >> 2, wc = wid & 3, fr = lane & 15, fq = lane >> 4;
    const int K = g.K, nt = K / BK;
    unsigned voffA[2], voffB[2];
#pragma unroll
    for (int i = 0; i < 2; ++i) { int R, C; stage_rc(tid * 16 + i * 8192, R, C); const int Rb = (R & ~31) + perm32(R & 31);
        voffA[i] = (unsigned)(R * g.lda + C) * 2u; voffB[i] = (unsigned)(Rb * g.ldb + C) * 2u; }
    const size_t kstep = (size_t)(BK * 2);
    const size_t hstepA = (size_t)HALF * g.lda * 2, tstepA = 2 * hstepA;
    const size_t hstepB = (size_t)HALF * g.ldb * 2, tstepB = 2 * hstepB;
    const unsigned ldsw = (unsigned)wid * 1024u;
    const int aoff = lds_byte(wr * 64 + fr, fq * 8), boff = lds_byte(wc * 32 + fr, fq * 8);
#define PG8_SA(b, h) (((b) * 2 + (h)) * HTB)
#define PG8_SB(b, h) ((4 + (b) * 2 + (h)) * HTB)
#define PG8_STAGE(bufoff, gbase, voff) do { _Pragma("unroll") for (int _i = 0; _i < 2; ++_i) \
        __builtin_amdgcn_global_load_lds((const unsigned*)((const char*)(gbase) + (voff)[_i]), (LAS unsigned*)(lds + (bufoff) + ldsw + _i * 8192), 16, 0, 0); } while (0)
#define PG8_LDA(dst, b, h) do { _Pragma("unroll") for (int m = 0; m < 4; ++m) _Pragma("unroll") for (int k = 0; k < 2; ++k) dst[m][k] = *(const LAS bf16x8*)(lds + PG8_SA(b, h) + aoff + m * 2048 + k * 1024); } while (0)
#define PG8_LDB(dst, b, h) do { _Pragma("unroll") for (int n = 0; n < 2; ++n) _Pragma("unroll") for (int k = 0; k < 2; ++k) dst[n][k] = *(const LAS bf16x8*)(lds + PG8_SB(b, h) + boff + n * 2048 + k * 1024); } while (0)
#define PG8_MMA(ai, bj, At, Bt) do { __builtin_amdgcn_s_setprio(1); _Pragma("unroll") for (int m = 0; m < 4; ++m) _Pragma("unroll") for (int n = 0; n < 2; ++n) _Pragma("unroll") for (int k = 0; k < 2; ++k) \
        acc[ai][bj][m][n] = __builtin_amdgcn_mfma_f32_16x16x32_bf16(Bt[n][k], At[m][k], acc[ai][bj][m][n], 0, 0, 0); __builtin_amdgcn_s_setprio(0); } while (0)
#define PG8_WAIT_V(n) asm volatile("s_waitcnt vmcnt(" #n ")" ::: "memory")
#define PG8_WAIT_L(n) asm volatile("s_waitcnt lgkmcnt(" #n ")" ::: "memory")
#define PG8_BAR __builtin_amdgcn_s_barrier()
#define PG8_SCHED __builtin_amdgcn_sched_barrier(0)
    Unit cur, nxt; int ui = 0;
    if (!S.next(0, cur)) return;
    f32x4 acc[2][2][4][2];
#pragma unroll
    for (int a = 0; a < 2; ++a)
#pragma unroll
        for (int b = 0; b < 2; ++b)
#pragma unroll
            for (int m = 0; m < 4; ++m)
#pragma unroll
                for (int n = 0; n < 2; ++n) acc[a][b][m][n] = (f32x4){0.f, 0.f, 0.f, 0.f};
    bf16x8 At[4][2], B0[2][2], B1[2][2];
    const char* cA = (const char*)g.A + (size_t)cur.pm * tstepA; const char* cB = (const char*)g.Bt + (size_t)cur.pn * tstepB;
    PG8_STAGE(PG8_SB(0, 0), cB, voffB); PG8_STAGE(PG8_SB(0, 1), cB + hstepB, voffB); PG8_STAGE(PG8_SA(0, 0), cA, voffA); PG8_STAGE(PG8_SA(0, 1), cA + hstepA, voffA);
    if (wr == 1) PG8_BAR;
    PG8_WAIT_V(2); PG8_BAR;
    PG8_STAGE(PG8_SB(1, 0), cB + kstep, voffB); PG8_STAGE(PG8_SA(1, 0), cA + kstep, voffA); PG8_STAGE(PG8_SB(1, 1), cB + hstepB + kstep, voffB);
    PG8_WAIT_V(6); PG8_BAR;
    for (;;) {
        const bool has_next = S.next(ui + 1, nxt);
        const char* nA = has_next ? (const char*)g.A + (size_t)nxt.pm * tstepA : cA; const char* nB = has_next ? (const char*)g.Bt + (size_t)nxt.pn * tstepB : cB;
        for (int t = 0; t < nt; t += 2) {
            const bool last = (t == nt - 2);
            const char* a1 = cA + (size_t)(t + 1) * kstep;
            const char* a2 = last ? nA : cA + (size_t)(t + 2) * kstep; const char* b2 = last ? nB : cB + (size_t)(t + 2) * kstep;
            const char* a3 = a2 + kstep; const char* b3 = b2 + kstep;
            PG8_LDB(B0, 0, 0); PG8_LDB(B1, 0, 1); PG8_SCHED; PG8_LDA(At, 0, 0); PG8_STAGE(PG8_SA(1, 1), a1 + hstepA, voffA);
            PG8_WAIT_V(8); PG8_WAIT_L(0); PG8_BAR; PG8_MMA(0, 0, At, B0); PG8_MMA(0, 1, At, B1); PG8_BAR; PG8_SCHED;
            PG8_LDA(At, 0, 1); PG8_STAGE(PG8_SB(0, 0), b2, voffB); PG8_STAGE(PG8_SB(0, 1), b2 + hstepB, voffB); PG8_STAGE(PG8_SA(0, 0), a2, voffA);
            PG8_WAIT_V(8); PG8_WAIT_L(0); PG8_BAR; PG8_MMA(1, 0, At, B0); PG8_MMA(1, 1, At, B1); PG8_BAR; PG8_SCHED;
            PG8_LDB(B0, 1, 0); PG8_LDB(B1, 1, 1); PG8_SCHED; PG8_LDA(At, 1, 0); PG8_STAGE(PG8_SA(0, 1), a2 + hstepA, voffA);
            PG8_WAIT_V(8); PG8_WAIT_L(0); PG8_BAR; PG8_MMA(0, 0, At, B0); PG8_MMA(0, 1, At, B1); PG8_BAR; PG8_SCHED;
            PG8_LDA(At, 1, 1); PG8_STAGE(PG8_SB(1, 0), b3, voffB); PG8_STAGE(PG8_SB(1, 1), b3 + hstepB, voffB); PG8_STAGE(PG8_SA(1, 0), a3, voffA);
            PG8_WAIT_V(8); PG8_WAIT_L(0); PG8_BAR; PG8_MMA(1, 0, At, B0); PG8_MMA(1, 1, At, B1); PG8_BAR; PG8_SCHED;
        }
        if (wr == 0) PG8_BAR;
        epi_run(E, acc, cur, wr, wc, fr, fq);
        if (!has_next) break;
#pragma unroll
        for (int a = 0; a < 2; ++a)
#pragma unroll
            for (int b = 0; b < 2; ++b)
#pragma unroll
                for (int m = 0; m < 4; ++m)
#pragma unroll
                    for (int n = 0; n < 2; ++n) acc[a][b][m][n] = (f32x4){0.f, 0.f, 0.f, 0.f};
        cur = nxt; cA = nA; cB = nB; ++ui;
        if (wr == 1) PG8_BAR;
    }
    PG8_WAIT_V(0);
    PG8_BAR;
#undef PG8_SA
#undef PG8_SB
#undef PG8_STAGE
#undef PG8_LDA
#undef PG8_LDB
#undef PG8_MMA
#undef PG8_WAIT_V
#undef PG8_WAIT_L
#undef PG8_BAR
#undef PG8_SCHED
}
}

#define XB_TMO      128
#define XB_XCNT(j)  (256  + 64 * (j))
#define XB_XSUB(j)  (1280 + 64 * (j))
#define XB_XGEN(j)  (2304 + 64 * (j))
#define XB_TOP      3328
#define XB_TOPGEN   3392
#define XCD_BAR_WORDS 3456
#define XB_SPIN_CAP (1u << 22)
__device__ __forceinline__ unsigned xb_ld(unsigned* p)              { return __hip_atomic_load(p, __ATOMIC_RELAXED, __HIP_MEMORY_SCOPE_AGENT); }
__device__ __forceinline__ unsigned xb_add(unsigned* p, unsigned v) { return __hip_atomic_fetch_add(p, v, __ATOMIC_RELAXED, __HIP_MEMORY_SCOPE_AGENT); }
__device__ __forceinline__ unsigned xb_xcc_id() { return (unsigned)__builtin_amdgcn_s_getreg((3 << 11) | 20) & 0xFu; }
#define XB_SPIN(cond, bar) do { unsigned _sp = 0; while (cond) { __builtin_amdgcn_s_sleep(1); \
    if ((++_sp & 255u) == 0u) { if (xb_ld(&(bar)[XB_TMO])) break; if (_sp > XB_SPIN_CAP) { atomicAdd(&(bar)[XB_TMO], 1u); break; } } } } while (0)
struct XcdBarrier { unsigned* bar; unsigned x; volatile LAS unsigned* st; };
__device__ __forceinline__ XcdBarrier xcd_barrier_post(unsigned* bar, volatile LAS unsigned* st) {
    XcdBarrier b; b.bar = bar; b.x = xb_xcc_id(); b.st = st;
    if (threadIdx.x == 0) (void)xb_add(&bar[XB_XCNT(b.x)], 1u);
    return b;
}
__device__ __forceinline__ void xcd_barrier_complete(unsigned* bar, unsigned x, unsigned& nloc, unsigned& nx) {
    const unsigned G = gridDim.x * gridDim.y * gridDim.z;
    unsigned sum, cnt, mine, sp = 0u;
    for (;;) {
        sum = 0u; cnt = 0u; mine = 0u;
#pragma unroll
        for (unsigned j = 0; j < 16; ++j) { const unsigned c = xb_ld(&bar[XB_XCNT(j)]); sum += c; cnt += (c > 0u) ? 1u : 0u; mine = (j == x) ? c : mine; }
        if (sum == G) break;
        __builtin_amdgcn_s_sleep(1);
        if ((++sp & 255u) == 0u) { if (xb_ld(&bar[XB_TMO])) break; if (sp > XB_SPIN_CAP) { atomicAdd(&bar[XB_TMO], 1u); break; } }
    }
    nloc = mine > 0u ? mine : 1u; nx = cnt > 0u ? cnt : 1u;
}
__device__ __forceinline__ void xcd_barrier(const XcdBarrier& b) {
    asm volatile("s_waitcnt vmcnt(0)" ::: "memory");
    __syncthreads();
    if (threadIdx.x == 0) {
        unsigned* bar = b.bar;
        __builtin_amdgcn_s_waitcnt(0);
        unsigned nloc = b.st[0], nx = b.st[1];
        if (nloc == 0u) { xcd_barrier_complete(bar, b.x, nloc, nx); b.st[0] = nloc; b.st[1] = nx; }
        const unsigned old = xb_add(&bar[XB_XSUB(b.x)], 1u);
        const unsigned gen = old / nloc;
        if (old + 1u == (gen + 1u) * nloc) {
            __builtin_amdgcn_fence(__ATOMIC_RELEASE, "agent");
            asm volatile("s_waitcnt vmcnt(0)" ::: "memory");
            const unsigned og = xb_add(&bar[XB_TOP], 1u);
            const unsigned tg = og / nx;
            if (og + 1u == (tg + 1u) * nx) xb_add(&bar[XB_TOPGEN], 1u);
            else XB_SPIN(xb_ld(&bar[XB_TOPGEN]) == tg, bar);
            __builtin_amdgcn_fence(__ATOMIC_ACQUIRE, "agent");
            xb_add(&bar[XB_XGEN(b.x)], 1u);
            asm volatile("s_waitcnt vmcnt(0)" ::: "memory");
        } else {
            XB_SPIN(xb_ld(&bar[XB_XGEN(b.x)]) == gen, bar);
            __builtin_amdgcn_fence(__ATOMIC_ACQUIRE, "agent");
            asm volatile("s_waitcnt vmcnt(0)" ::: "memory");
        }
    }
    __syncthreads();
}

struct Params { const float* in[22]; float* out; unsigned char* ws; int ph_lo, ph_hi; };

__device__ __forceinline__ void ssm_prep(LAS unsigned char* lds, const Params& p, int g) {
    const float* a_re = p.in[4]; const float* a_im = p.in[5]; const float* log_dt = p.in[6];
    const float* b_re = p.in[7]; const float* b_im = p.in[8]; const float* c_re = p.in[9]; const float* c_im = p.in[10]; const float* dskip = p.in[11];
    LAS float* apow = (LAS float*)lds;
    LAS float* Bb = apow + 2 * 17 * 64 * 2;
    LAS float* Cc = Bb + 2 * 64 * 16 * 2;
    LAS float* Kt = Cc + 2 * 16 * 64 * 2;
    const int tid = ltid();
    for (int idx = tid; idx < 2 * 17 * 64; idx += 512) {
        const int dir = idx / (17 * 64), j = (idx / 64) % 17, pp = idx % 64;
        const float are = a_re[(dir * 64 + g) * 64 + pp], aim = a_im[(dir * 64 + g) * 64 + pp], dt = expf(log_dt[dir * 64 + g]);
        const float x = are * dt * (float)j, y = aim * dt * (float)j; const float mag = expf(x); float s, c; sincosf(y, &s, &c);
        apow[idx * 2] = mag * c; apow[idx * 2 + 1] = mag * s;
    }
    for (int idx = tid; idx < 2 * 64 * 16; idx += 512) {
        const int dir = idx / 1024, pp = (idx / 16) % 64, c = idx % 16;
        const float are = a_re[(dir * 64 + g) * 64 + pp], aim = a_im[(dir * 64 + g) * 64 + pp], dt = expf(log_dt[dir * 64 + g]);
        const float x = are * dt, y = aim * dt; const float ex1 = expm1f(x); float sy, cy; sincosf(y, &sy, &cy); const float sh = sinf(0.5f * y);
        const float nr = ex1 * cy - 2.0f * sh * sh, ni = (ex1 + 1.0f) * sy;
        const float den = are * are + aim * aim; const float qr = (nr * are + ni * aim) / den, qi = (ni * are - nr * aim) / den;
        const float br = b_re[((dir * 64 + g) * 64 + pp) * 16 + c], bi = b_im[((dir * 64 + g) * 64 + pp) * 16 + c];
        Bb[idx * 2] = qr * br - qi * bi; Bb[idx * 2 + 1] = qr * bi + qi * br;
    }
    for (int idx = tid; idx < 2 * 16 * 64; idx += 512) {
        const int dir = idx / 1024, c = (idx / 64) % 16, pp = idx % 64;
        Cc[idx * 2] = c_re[((dir * 64 + g) * 16 + c) * 64 + pp]; Cc[idx * 2 + 1] = c_im[((dir * 64 + g) * 16 + c) * 64 + pp];
    }
    __syncthreads();
    for (int idx = tid; idx < 8192; idx += 512) {
        const int dir = idx >> 12, j = (idx >> 8) & 15, c = (idx >> 4) & 15, c2 = idx & 15;
        float acc = 0.f;
        for (int pp = 0; pp < 64; ++pp) {
            const float ar = apow[((dir * 17 + j) * 64 + pp) * 2], ai = apow[((dir * 17 + j) * 64 + pp) * 2 + 1];
            const float cr = Cc[((dir * 16 + c) * 64 + pp) * 2], ci = Cc[((dir * 16 + c) * 64 + pp) * 2 + 1];
            const float br = Bb[((dir * 64 + pp) * 16 + c2) * 2], bi = Bb[((dir * 64 + pp) * 16 + c2) * 2 + 1];
            const float wr = cr * ar - ci * ai, wi = cr * ai + ci * ar;
            acc += wr * br - wi * bi;
        }
        Kt[idx] = acc;
    }
    bf16_t* bty = (bf16_t*)((unsigned char*)p.out + DO_BTY) + (size_t)g * 256 * 512;
    bf16_t* bts = (bf16_t*)((unsigned char*)p.out + DO_BTS) + (size_t)g * 256 * 256;
    for (int idx = tid; idx < 65536; idx += 512) {
        const int n = idx >> 8, kk = idx & 255, t = n >> 4, c = n & 15, dir = kk >> 7, reim = (kk >> 6) & 1, pp = kk & 63;
        const int j = dir == 0 ? t + 1 : 16 - t;
        const float ar = apow[((dir * 17 + j) * 64 + pp) * 2], ai = apow[((dir * 17 + j) * 64 + pp) * 2 + 1];
        const float cr = Cc[((dir * 16 + c) * 64 + pp) * 2], ci = Cc[((dir * 16 + c) * 64 + pp) * 2 + 1];
        const float wr = cr * ar - ci * ai, wi = cr * ai + ci * ar;
        bty[n * 512 + 256 + kk] = f2bf(reim == 0 ? wr : -wi);
    }
    for (int idx = tid; idx < 65536; idx += 512) {
        const int n = idx >> 8, kk = idx & 255, dir = n >> 7, reim = (n >> 6) & 1, pp = n & 63, s = kk >> 4, c2 = kk & 15;
        const int j = dir == 0 ? 15 - s : s;
        const float ar = apow[((dir * 17 + j) * 64 + pp) * 2], ai = apow[((dir * 17 + j) * 64 + pp) * 2 + 1];
        const float br = Bb[((dir * 64 + pp) * 16 + c2) * 2], bi = Bb[((dir * 64 + pp) * 16 + c2) * 2 + 1];
        const float wr = ar * br - ai * bi, wi = ar * bi + ai * br;
        bts[n * 256 + kk] = f2bf(reim == 0 ? wr : wi);
    }
    __syncthreads();
    for (int idx = tid; idx < 65536; idx += 512) {
        const int n = idx >> 8, kk = idx & 255, t = n >> 4, c = n & 15, s = kk >> 4, c2 = kk & 15;
        float v = 0.f;
        if (s <= t) v += Kt[(((t - s)) * 16 + c) * 16 + c2];
        if (s >= t) v += Kt[((16 + (s - t)) * 16 + c) * 16 + c2];
        if (s == t && c == c2) v += dskip[g * 16 + c];
        bty[n * 512 + kk] = f2bf(v);
    }
    __syncthreads();
}

__device__ __forceinline__ int t5_bucket(int rel) {
    const int ret = rel > 0 ? 16 : 0; const int n = rel < 0 ? -rel : rel;
    if (n < 8) return ret + n;
    int large = 8 + (int)(logf((float)n / 8.0f) / 4.852030263919617f * 8.0f);
    large = large < 15 ? large : 15;
    return ret + large;
}

constexpr int RMS_NR = 4;
template <bool OUT_BF16>
__device__ __forceinline__ void rms_rows(const float* s0, const float* s1, const float* gam, void* dst, int G) {
    const int tid_ = ltid(); const int lane = tid_ & 63, gw = blockIdx.x * 8 + (tid_ >> 6), nw = G * 8;
    for (int r0 = gw; r0 < M_TOK; r0 += RMS_NR * nw) {
        f32x4 v[RMS_NR][8]; float ss[RMS_NR];
#pragma unroll
        for (int q = 0; q < RMS_NR; ++q) {
            const int r = r0 + q * nw, rc = r < M_TOK ? r : r0;
            const float* src = (s1 != nullptr && rc >= 32768) ? s1 + (size_t)(rc - 32768) * DM : s0 + (size_t)rc * DM;
#pragma unroll
            for (int j = 0; j < 8; ++j) v[q][j] = *(const f32x4*)(src + (j * 64 + lane) * 4);
        }
#pragma unroll
        for (int q = 0; q < RMS_NR; ++q) { float a = 0.f;
#pragma unroll
            for (int j = 0; j < 8; ++j) a += v[q][j][0] * v[q][j][0] + v[q][j][1] * v[q][j][1] + v[q][j][2] * v[q][j][2] + v[q][j][3] * v[q][j][3];
#pragma unroll
            for (int o = 32; o >= 1; o >>= 1) a += __shfl_xor(a, o);
            ss[q] = rsqrtf(a * (1.0f / DM) + 1e-6f); }
#pragma unroll
        for (int j = 0; j < 8; ++j) {
            const f32x4 gg = *(const f32x4*)(gam + (j * 64 + lane) * 4);
#pragma unroll
            for (int q = 0; q < RMS_NR; ++q) {
                const int r = r0 + q * nw; if (r >= M_TOK) continue;
                const f32x4 y = v[q][j] * ss[q] * gg;
                if constexpr (OUT_BF16) { u32x2 w; w.x = cvt_pk_bf16(y[0], y[1]); w.y = cvt_pk_bf16(y[2], y[3]); *(u32x2*)((bf16_t*)dst + (size_t)r * DM + (j * 64 + lane) * 4) = w; }
                else *(f32x4*)((float*)dst + (size_t)r * DM + (j * 64 + lane) * 4) = y;
            }
        }
    }
}

template <bool OUT_BF16>
__device__ __forceinline__ void rms_rows_b16(const bf16_t* src, const float* gam, void* dst, int G) {
    const int tid_ = ltid(); const int lane = tid_ & 63, gw = blockIdx.x * 8 + (tid_ >> 6), nw = G * 8;
    for (int r0 = gw; r0 < M_TOK; r0 += RMS_NR * nw) {
        u32x4 v[RMS_NR][4]; float ss[RMS_NR];
#pragma unroll
        for (int q = 0; q < RMS_NR; ++q) {
            const int r = r0 + q * nw, rc = r < M_TOK ? r : r0;
#pragma unroll
            for (int j = 0; j < 4; ++j) v[q][j] = *(const u32x4*)(src + (size_t)rc * DM + (j * 64 + lane) * 8);
        }
#pragma unroll
        for (int q = 0; q < RMS_NR; ++q) { float a = 0.f;
#pragma unroll
            for (int j = 0; j < 4; ++j) { f32x4 x0, x1; unpack8(v[q][j], x0, x1); a += (x0[0] * x0[0] + x0[1] * x0[1]) + (x0[2] * x0[2] + x0[3] * x0[3]) + (x1[0] * x1[0] + x1[1] * x1[1]) + (x1[2] * x1[2] + x1[3] * x1[3]); }
#pragma unroll
            for (int o = 32; o >= 1; o >>= 1) a += __shfl_xor(a, o);
            ss[q] = rsqrtf(a * (1.0f / DM) + 1e-6f); }
#pragma unroll
        for (int j = 0; j < 4; ++j) {
            const f32x4 g0 = *(const f32x4*)(gam + (j * 64 + lane) * 8), g1 = *(const f32x4*)(gam + (j * 64 + lane) * 8 + 4);
#pragma unroll
            for (int q = 0; q < RMS_NR; ++q) {
                const int r = r0 + q * nw; if (r >= M_TOK) continue;
                f32x4 x0, x1; unpack8(v[q][j], x0, x1);
                const f32x4 y0 = x0 * ss[q] * g0, y1 = x1 * ss[q] * g1;
                if constexpr (OUT_BF16) *(u32x4*)((bf16_t*)dst + (size_t)r * DM + (j * 64 + lane) * 8) = pack8(y0, y1);
                else { float* d = (float*)dst + (size_t)r * DM + (j * 64 + lane) * 8; *(f32x4*)d = y0; *(f32x4*)(d + 4) = y1; }
            }
        }
    }
}

__device__ __forceinline__ void prep_phase(LAS unsigned char* lds, const Params& p, int G) {
    const int tid = ltid();
    for (int g = blockIdx.x; g < 64; g += G) ssm_prep(lds, p, g);
    if ((int)blockIdx.x == G - 1) {
        float* bt = (float*)(p.ws + WS_BIAS); const float* rb = p.in[20];
        for (int idx = tid; idx < 12 * 129; idx += 512) { const int head = idx / 129, ri = idx % 129, d = 1 << (2 * (head >> 2));
            bt[head * 132 + ri] = rb[t5_bucket((ri - 64) * d) * 12 + head] * 1.4426950408889634f; }
    }
    {
        const float* srcs[7] = {p.in[3], p.in[12], p.in[14], p.in[15], p.in[16], p.in[18], p.in[19]};
        const size_t dofs[7] = {DO_WIN, DO_WGLU, DO_WBS, DO_WBA, DO_WOUT, DO_WFF1, DO_WFF2};
        const int Ks[7] = {2048, 1024, 1024, 512, 2048, 2048, 8192}, Ns[7] = {9728, 1024, 2048, 2048, 2048, 8192, 2048};
        LAS float* tl = (LAS float*)lds;
        int total = 0;
#pragma unroll
        for (int w = 0; w < 7; ++w) total += (Ks[w] / 64) * (Ns[w] / 64);
        const int tskew = G > 128 ? 64 : 0;
        for (int tile0 = (int)blockIdx.x - tskew; tile0 < total; tile0 += 2 * (G - tskew)) {
            if (tile0 < 0) break;
            float ld[2][8]; bf16_t* dsts[2]; int Kq[2], k0q[2], n0q[2]; bool okq[2];
#pragma unroll
            for (int q = 0; q < 2; ++q) {
                const int tile = tile0 + q * (G - tskew); okq[q] = tile < total;
                int w = 0, tt = okq[q] ? tile : tile0; const float* src = srcs[0]; size_t dof = dofs[0]; int K = Ks[0], N = Ns[0];
#pragma unroll
                for (int qq = 0; qq < 6; ++qq) { const int cnt = (Ks[qq] / 64) * (Ns[qq] / 64); if (w == qq && tt >= cnt) { tt -= cnt; w = qq + 1; src = srcs[qq + 1]; dof = dofs[qq + 1]; K = Ks[qq + 1]; N = Ns[qq + 1]; } }
                const int ntn = N / 64, k0 = (tt / ntn) * 64, n0 = (tt % ntn) * 64;
                dsts[q] = (bf16_t*)((unsigned char*)p.out + dof); Kq[q] = K; k0q[q] = k0; n0q[q] = n0;
                const int j = tid & 63, i0 = tid >> 6;
#pragma unroll
                for (int ii = 0; ii < 8; ++ii) { const int i = i0 + 8 * ii; ld[q][ii] = src[(size_t)(k0 + i) * N + n0 + j]; }
            }
#pragma unroll
            for (int q = 0; q < 2; ++q) { const int j = tid & 63, i0 = tid >> 6;
#pragma unroll
                for (int ii = 0; ii < 8; ++ii) { const int i = i0 + 8 * ii; tl[q * 64 * 65 + i * 65 + j] = ld[q][ii]; } }
            __syncthreads();
#pragma unroll
            for (int q = 0; q < 2; ++q) { if (!okq[q]) continue; const int kp = tid & 31, nn0 = tid >> 5;
#pragma unroll
                for (int jj = 0; jj < 4; ++jj) { const int nn = nn0 + 16 * jj;
                    *(unsigned*)(dsts[q] + (size_t)(n0q[q] + nn) * Kq[q] + k0q[q] + 2 * kp) = cvt_pk_bf16(tl[q * 64 * 65 + (2 * kp) * 65 + nn], tl[q * 64 * 65 + (2 * kp + 1) * 65 + nn]); } }
            __syncthreads();
        }
    }
    rms_rows<true>(p.in[0], p.in[1], p.in[2], (void*)((unsigned char*)p.out + DO_XN), G);
}

constexpr int VS_PITCH = 288, VS_ROWS = 208, VS_BYTES = VS_ROWS * VS_PITCH;
struct AttnItem { int head, dsh, r, pos0, seq_base, m, i0; };
__device__ __forceinline__ AttnItem attn_item(int it) {
    AttnItem a; a.head = it / 768; const int pb = it - a.head * 768, gi = a.head >> 2; a.dsh = gi * 2;
    const int p0 = pb * 64; int lsh; if (p0 < 32768) { a.seq_base = p0 & ~8191; lsh = 13; } else { a.seq_base = 32768; lsh = 14; }
    const int lm = lsh - a.dsh; a.m = 1 << lm; const int local = p0 - a.seq_base; a.r = local >> lm; a.i0 = local - (a.r << lm);
    a.pos0 = a.seq_base + (a.i0 << a.dsh); return a;
}
__device__ __forceinline__ int attn_pair(int j, int c, int G) {
    if ((G & 7) == 0 && (4608 % G) == 0) { const int per_xcd = 4608 / 8, wpx = G >> 3; return (c & 7) * per_xcd + j * wpx + (c >> 3); }
    return j * G + c;
}
__device__ __forceinline__ void attn_load_v(const AttnItem& a, const bf16_t* qkv, int ht, u32x4 (&vreg)[12]) {
#pragma unroll
    for (int pass = 0; pass < 12; ++pass) {
        const int row = pass * 16 + (ht >> 4), ch = ht & 15, ki = a.i0 - 64 + row;
        u32x4 val = (u32x4){0u, 0u, 0u, 0u};
        if (ki >= 0 && ki < a.m) val = *(const u32x4*)(qkv + ((size_t)(24 + a.head) * M_TOK + a.seq_base + a.r * a.m + ki) * 128 + ch * 8);
        vreg[pass] = val;
    }
}
template <bool EDGE>
__device__ __forceinline__ float attn_scores(f32x4 (&sa)[10], const LAS float* bsl, int dl, int kabs0, int m, float scale2) {
    float mx = -3.0e38f;
#pragma unroll
    for (int t9 = 0; t9 < 9; ++t9)
#pragma unroll
        for (int j = 0; j < 4; ++j) {
            bool valid = true;
            if (t9 == 0) valid = (j + dl >= 0);
            if (t9 == 8) valid = (j + dl <= 0);
            if (EDGE) { const int kabs = kabs0 + 16 * t9 + j; valid = valid && (kabs >= 0) && (kabs < m); }
            float sv = sa[t9][j] * scale2 + bsl[16 * t9 + j];
            sv = valid ? sv : -1.0e30f;
            sa[t9][j] = sv; mx = fmaxf(mx, sv);
        }
    return mx;
}
__device__ __forceinline__ void attn_phase(LAS unsigned char* lds, bf16_t* qkv, float* lse, const float* biasT, int G) {
    const int tid = ltid(), wave = __builtin_amdgcn_readfirstlane(tid >> 6), lane = tid & 63, half = wave >> 2, w4 = wave & 3, li = lane & 15, lg = lane >> 4, ht = tid & 255;
    LAS unsigned char* vs = lds + half * VS_BYTES;
    LAS float* bs = (LAS float*)(lds + 2 * VS_BYTES + half * 1024);
    const float scale2 = 0.08838834764831845f * 1.4426950408889634f;
    for (int i = ht; i < 16 * VS_PITCH / 16; i += 256) *(LAS u32x4*)(vs + 192 * VS_PITCH + i * 16) = (u32x4){0u, 0u, 0u, 0u};
    if (ht < 176) bs[ht] = 0.f;
    const int dl = 4 * lg - li, q4 = li >> 2, p4 = li & 3;
    const LAS float* bsl = bs + 16 + dl;
    const LAS unsigned char* vrd = vs + (16 * w4 + 4 * lg + q4) * VS_PITCH + (4 * p4) * 2;
    u32x4 vreg[12];
    const int nrounds = (4608 + G - 1) / G, cwg = blockIdx.x;
    { const int pair0 = attn_pair(0, cwg, G); if (pair0 < 4608) { const AttnItem a = attn_item(pair0 * 2 + half); attn_load_v(a, qkv, ht, vreg); } }
    __syncthreads();
    for (int j = 0; j < nrounds; ++j) {
        const int pair = attn_pair(j, cwg, G); if (pair >= 4608) break;
        const int pairn = (j + 1 < nrounds) ? attn_pair(j + 1, cwg, G) : 4608;
        const AttnItem a = attn_item(pair * 2 + half);
#pragma unroll
        for (int pass = 0; pass < 12; ++pass) *(LAS u32x4*)(vs + (pass * 16 + (ht >> 4)) * VS_PITCH + (ht & 15) * 16) = vreg[pass];
        if (ht < 129) bs[16 + ht] = biasT[a.head * 132 + ht];
        __syncthreads();
        const size_t tokq = (size_t)(a.pos0 + a.r + ((16 * w4 + li) << a.dsh));
        const int pbase = a.seq_base + a.r * a.m;
        bf16_t* qp = qkv + ((size_t)a.head * M_TOK + pbase + a.i0 + 16 * w4 + li) * 128;
        bf16x8 Qf[4];
#pragma unroll
        for (int ks = 0; ks < 4; ++ks) Qf[ks] = *(const bf16x8*)(qp + 32 * ks + 8 * lg);
        const int kbase = a.i0 - 64 + 16 * w4 + li;
        const bf16_t* kcol = qkv + ((size_t)(12 + a.head) * M_TOK + pbase) * 128 + 8 * lg;
        f32x4 sa[10];
        bf16x8 Kf[2][3][4];
#define ATT_LOADK(buf, grp) do { _Pragma("unroll") for (int tt = 0; tt < 3; ++tt) { int ki = kbase + 16 * ((grp) * 3 + tt); ki = ki < 0 ? 0 : (ki > a.m - 1 ? a.m - 1 : ki); \
            const bf16_t* kp = kcol + (size_t)ki * 128; \
            _Pragma("unroll") for (int ks = 0; ks < 4; ++ks) Kf[buf][tt][ks] = *(const bf16x8*)(kp + 32 * ks); } } while (0)
#define ATT_MMAK(buf, grp) do { _Pragma("unroll") for (int tt = 0; tt < 3; ++tt) { f32x4 acc_ = (f32x4){0.f, 0.f, 0.f, 0.f}; \
            _Pragma("unroll") for (int ks = 0; ks < 4; ++ks) acc_ = __builtin_amdgcn_mfma_f32_16x16x32_bf16(Kf[buf][tt][ks], Qf[ks], acc_, 0, 0, 0); sa[(grp) * 3 + tt] = acc_; } } while (0)
        ATT_LOADK(0, 0); ATT_LOADK(1, 1);
        __builtin_amdgcn_sched_barrier(0);
        ATT_MMAK(0, 0);
        __builtin_amdgcn_sched_barrier(0);
        ATT_LOADK(0, 2);
        if (pairn < 4608) { const AttnItem an = attn_item(pairn * 2 + half); attn_load_v(an, qkv, ht, vreg); }
        __builtin_amdgcn_sched_barrier(0);
        ATT_MMAK(1, 1);
        ATT_MMAK(0, 2);
#undef ATT_LOADK
#undef ATT_MMAK
        sa[9] = (f32x4){0.f, 0.f, 0.f, 0.f};
        const int kabs0 = a.i0 - 64 + 16 * w4 + 4 * lg;
        const bool edge = (a.i0 == 0) || (a.i0 + 64 == a.m);
        float mx = edge ? attn_scores<true>(sa, bsl, dl, kabs0, a.m, scale2) : attn_scores<false>(sa, bsl, dl, kabs0, a.m, scale2);
        mx = fmaxf(mx, __shfl_xor(mx, 16)); mx = fmaxf(mx, __shfl_xor(mx, 32));
        float sum = 0.f;
#pragma unroll
        for (int t9 = 0; t9 < 9; ++t9)
#pragma unroll
            for (int j = 0; j < 4; ++j) { const float pv = __builtin_amdgcn_exp2f(sa[t9][j] - mx); sa[t9][j] = pv; sum += pv; }
        sum += __shfl_xor(sum, 16); sum += __shfl_xor(sum, 32);
        bf16x8 Pf[5];
#pragma unroll
        for (int s5 = 0; s5 < 5; ++s5) {
            u32x4 w; w.x = cvt_pk_bf16(sa[2 * s5][0], sa[2 * s5][1]); w.y = cvt_pk_bf16(sa[2 * s5][2], sa[2 * s5][3]);
            w.z = cvt_pk_bf16(sa[2 * s5 + 1][0], sa[2 * s5 + 1][1]); w.w = cvt_pk_bf16(sa[2 * s5 + 1][2], sa[2 * s5 + 1][3]);
            Pf[s5] = __builtin_bit_cast(bf16x8, w);
        }
        const float inv = 1.0f / sum;
        f32x4 o[8];
#pragma unroll
        for (int dt = 0; dt < 8; ++dt) o[dt] = (f32x4){0.f, 0.f, 0.f, 0.f};
#pragma unroll
        for (int s5 = 0; s5 < 5; ++s5) {
            s16x4 va[8], vb[8];
#pragma unroll
            for (int dt = 0; dt < 8; ++dt) {
                va[dt] = __builtin_amdgcn_ds_read_tr16_b64_v4i16((LAS s16x4*)(vrd + (32 * s5) * VS_PITCH + 32 * dt));
                vb[dt] = __builtin_amdgcn_ds_read_tr16_b64_v4i16((LAS s16x4*)(vrd + (32 * s5 + 16) * VS_PITCH + 32 * dt));
            }
#pragma unroll
            for (int dt = 0; dt < 8; ++dt) {
                const bf16x8 Vf = (bf16x8){va[dt][0], va[dt][1], va[dt][2], va[dt][3], vb[dt][0], vb[dt][1], vb[dt][2], vb[dt][3]};
                o[dt] = __builtin_amdgcn_mfma_f32_16x16x32_bf16(Vf, Pf[s5], o[dt], 0, 0, 0);
            }
        }
#pragma unroll
        for (int dt = 0; dt < 8; ++dt) {
            const f32x4 ov = o[dt] * inv;
            u32x2 w; w.x = cvt_pk_bf16(ov[0], ov[1]); w.y = cvt_pk_bf16(ov[2], ov[3]);
            *(u32x2*)(qp + 16 * dt + 4 * lg) = w;
        }
        if (lg == 0) lse[tokq * 12 + a.head] = (mx + __log2f(sum)) * 0.6931471805599453f;
        __syncthreads();
    }
}

__device__ __forceinline__ void scan_merge_phase(const Params& p, int G) {
    const int tid = ltid(), lane = tid & 63;
    const bf16_t* S = (const bf16_t*)((unsigned char*)p.out + DO_XN);
    bf16_t* assm = (bf16_t*)(p.ws + WS_ASSM);
    for (int item = (tid >> 6) * G + blockIdx.x; item < 640; item += 8 * G) {
        const int g = item & 63, dir = (item >> 6) & 1, seq = item >> 7;
        const int n0 = seq < 4 ? seq * 512 : 2048, len = seq < 4 ? 512 : 1024;
        const float are = p.in[4][(dir * 64 + g) * 64 + lane], aim = p.in[5][(dir * 64 + g) * 64 + lane], dt = expf(p.in[6][dir * 64 + g]);
        const float mag = expf(16.0f * are * dt); float sn, cs; sincosf(16.0f * aim * dt, &sn, &cs);
        const float ar = mag * cs, ai = mag * sn;
        float hr = 0.f, hi = 0.f;
        const int nstart = dir == 0 ? n0 : n0 + len - 1; const long step = dir == 0 ? 1 : -1;
        const bf16_t* Sp = S + ((size_t)g * NCHUNK + nstart) * 256 + dir * 128 + lane;
        bf16_t* Ap = assm + ((size_t)g * NCHUNK + nstart) * 512 + 256 + dir * 128 + lane;
        const long sS = step * 256, sA = step * 512;
        float sr[2][16], si[2][16];
#define SCAN_LOAD(buf, b) do { _Pragma("unroll") for (int k = 0; k < 16; ++k) { sr[buf][k] = __uint_as_float((unsigned)Sp[((b) + k) * sS] << 16); si[buf][k] = __uint_as_float((unsigned)Sp[((b) + k) * sS + 64] << 16); } } while (0)
#define SCAN_STEP(buf, b) do { _Pragma("unroll") for (int k = 0; k < 16; ++k) { Ap[((b) + k) * sA] = f2bf(hr); Ap[((b) + k) * sA + 64] = f2bf(hi); \
            const float nr = ar * hr - ai * hi + sr[buf][k], ni = ar * hi + ai * hr + si[buf][k]; hr = nr; hi = ni; } } while (0)
        SCAN_LOAD(0, 0);
        for (int b = 0; b < len; b += 32) {
            SCAN_LOAD(1, b + 16);
            SCAN_STEP(0, b);
            if (b + 32 < len) SCAN_LOAD(0, b + 32);
            SCAN_STEP(1, b + 16);
        }
#undef SCAN_LOAD
#undef SCAN_STEP
    }
    const bf16_t* o = (const bf16_t*)(p.ws + WS_QKV); const float* lse = (const float*)(p.ws + WS_LSE);
    bf16_t* ya = (bf16_t*)((unsigned char*)p.out + DO_YATT);
    for (int idx0 = blockIdx.x * 512 + tid; idx0 < M_TOK * 64; idx0 += 2 * G * 512) {
        f32x4 a0[2], a1[2], b0[2], b1[2], c0[2], c1[2]; float w0[2], w1[2], w2[2];
#pragma unroll
        for (int q = 0; q < 2; ++q) {
            const int idx = idx0 + q * G * 512 < M_TOK * 64 ? idx0 + q * G * 512 : idx0;
            const int tok = idx >> 6, hh = (idx >> 4) & 3, ch = idx & 15;
            const float l0 = lse[tok * 12 + hh], l1 = lse[tok * 12 + 4 + hh], l2 = lse[tok * 12 + 8 + hh];
            int sbase, lsh; if (tok < 32768) { sbase = tok & ~8191; lsh = 13; } else { sbase = 32768; lsh = 14; }
            const int local = tok - sbase;
            const int p1 = sbase + ((local & 3) << (lsh - 2)) + (local >> 2), p2 = sbase + ((local & 15) << (lsh - 4)) + (local >> 4);
            unpack8(*(const u32x4*)(o + ((size_t)hh * M_TOK + tok) * 128 + ch * 8), a0[q], a1[q]);
            unpack8(*(const u32x4*)(o + ((size_t)(4 + hh) * M_TOK + p1) * 128 + ch * 8), b0[q], b1[q]);
            unpack8(*(const u32x4*)(o + ((size_t)(8 + hh) * M_TOK + p2) * 128 + ch * 8), c0[q], c1[q]);
            const float mx = fmaxf(l0, fmaxf(l1, l2)); w0[q] = __expf(l0 - mx); w1[q] = __expf(l1 - mx); w2[q] = __expf(l2 - mx);
            const float inv = 1.0f / (w0[q] + w1[q] + w2[q]); w0[q] *= inv; w1[q] *= inv; w2[q] *= inv;
        }
#pragma unroll
        for (int q = 0; q < 2; ++q) {
            const int idx = idx0 + q * G * 512; if (idx >= M_TOK * 64) continue;
            const int tok = idx >> 6, hh = (idx >> 4) & 3, ch = idx & 15;
            *(u32x4*)(ya + (size_t)tok * 512 + hh * 128 + ch * 8) = pack8(a0[q] * w0[q] + b0[q] * w1[q] + c0[q] * w2[q], a1[q] * w0[q] + b1[q] * w1[q] + c1[q] * w2[q]);
        }
    }
}

template <bool COOP>
__global__ void __launch_bounds__(512, 2) fwd_kernel(Params p) {
    extern __shared__ __attribute__((aligned(16))) unsigned char lds_raw[];
    LAS unsigned char* lds = (LAS unsigned char*)lds_raw;
    const int G = gridDim.x;
    XcdBarrier xb; xb.bar = (unsigned*)(p.ws + WS_BAR); xb.x = 0; xb.st = (volatile LAS unsigned*)(lds + 131072);
    bool posted = false; unsigned bar_target = 0;
    if constexpr (COOP) {
        if (threadIdx.x < 4) ((LAS unsigned*)(lds + 131072))[threadIdx.x] = 0u;
        if (blockIdx.x == 0) for (int i = threadIdx.x; i < XCD_BAR_WORDS; i += 512) __hip_atomic_store(xb.bar + i, 0u, __ATOMIC_RELAXED, __HIP_MEMORY_SCOPE_AGENT);
        __syncthreads();
    }
    for (int ph = p.ph_lo; ph < p.ph_hi; ++ph)
    for (int rep = 0; rep < (((PROBE_MASK >> ph) & 1u) ? 2 : 1); ++rep) {
        if ((ph > p.ph_lo || rep > 0) && !(COOP && ph == 7)) { if constexpr (COOP) {
            if (BAR_MODE == 0) cg::this_grid().sync();
            else if (!posted) { cg::this_grid().sync(); if (BAR_MODE == 1) xb = xcd_barrier_post((unsigned*)(p.ws + WS_BAR), (volatile LAS unsigned*)(lds + 131072)); posted = true; }
            else if (BAR_MODE == 1) xcd_barrier(xb);
            else {
                asm volatile("s_waitcnt vmcnt(0)" ::: "memory");
                __syncthreads();
                if (threadIdx.x == 0) {
                    unsigned* ctr = (unsigned*)(p.ws + WS_BAR) + XB_TOP;
                    __threadfence();
                    (void)xb_add(ctr, 1u);
                    bar_target += (unsigned)G;
                    unsigned sp = 0;
                    while (xb_ld(ctr) < bar_target) { __builtin_amdgcn_s_sleep(1); if (++sp > (1u << 24)) break; }
                    __threadfence();
                    asm volatile("s_waitcnt vmcnt(0)" ::: "memory");
                }
                __syncthreads();
            }
        } }
        unsigned char* ws = lptr(p.ws); unsigned char* dob = lptr((unsigned char*)p.out);
        const bf16_t* hb16 = (const bf16_t*)(ws + WS_GATES); const bf16_t* hfin16 = hb16 + (size_t)M_TOK * DM;
        if (ph == 0) { prep_phase(lds, p, G); continue; }
        if (ph == 3) { scan_merge_phase(p, G); continue; }
        if (ph == 9) { rms_rows_b16<true>(hb16, p.in[17], (void*)(dob + DO_XN), G); continue; }
        if (ph == N_PHASES - 1) { rms_rows_b16<false>(hfin16, p.in[21], (void*)p.out, G); continue; }
        bf16_t* assm = (bf16_t*)(ws + WS_ASSM); bf16_t* z = (bf16_t*)(dob + DO_XN);
        pg8::GemmD g; pg8::Sched S; pg8::Epi E;
        E.ws = ws; E.dob = dob; E.bglu = p.in[13]; E.x0 = p.in[0]; E.x1 = p.in[1]; E.hoff = 0;
        S.G = G; S.c = blockIdx.x; S.ssm = 0; S.nM = M_TOK / 256;
        if (ph == 1) { g = {z, (const bf16_t*)(dob + DO_WIN), DM, DM, DM}; S.nN = 38; E.mode = pg8::EM_INPROJ; }
        else if (ph == 2) { g = {assm, (const bf16_t*)(dob + DO_BTS), 512, 256, 256}; S.ssm = 1; S.nM = 768; S.nN = 1; E.mode = pg8::EM_SSM_S; }
        else if (ph == 4) { g = {assm, (const bf16_t*)(dob + DO_BTY), 512, 512, 512}; S.ssm = 1; S.nM = 768; S.nN = 1; E.mode = pg8::EM_SSM_Y; }
        else if (ph == 5) { g = {z, (const bf16_t*)(dob + DO_WGLU), SSMW, SSMW, SSMW}; S.nN = 4; E.mode = pg8::EM_GLU; }
        else if (ph == 6) { g = {z + (size_t)M_TOK * SSMW, (const bf16_t*)(dob + DO_WBS), SSMW, SSMW, SSMW}; S.nN = 8; E.mode = pg8::EM_BR1; }
        else if (ph == 7) { g = {(const bf16_t*)(dob + DO_YATT), (const bf16_t*)(dob + DO_WBA), 512, 512, 512}; S.nN = 8; E.mode = pg8::EM_BR2; }
        else if (ph == 8) { g = {(const bf16_t*)(ws + WS_QKV), (const bf16_t*)(dob + DO_WOUT), DM, DM, DM}; S.nN = 8; E.mode = pg8::EM_OUT; }
        else {
            const int c = (ph - 10) >> 1;
            if (((ph - 10) & 1) == 0) { g = {z + (size_t)c * FF_ROWS * DM, (const bf16_t*)(dob + DO_WFF1), DM, DM, DM}; S.nM = FF_ROWS / 256; S.nN = 32; E.mode = pg8::EM_FF1; }
            else { g = {(const bf16_t*)(ws + WS_QKV), (const bf16_t*)(dob + DO_WFF2), DFF, DFF, DFF}; S.nM = FF_ROWS / 256; S.nN = 8; E.mode = pg8::EM_FF2; E.hoff = (size_t)c * FF_ROWS * DM; }
        }
        S.nwg = S.nM * S.nN;
        pg8::gemm_phase(lds, g, S, E);
        if (ph == 2) attn_phase(lds, (bf16_t*)(ws + WS_QKV), (float*)(ws + WS_LSE), (const float*)(ws + WS_BIAS), G);
    }
}

extern "C" void kernel_launch(void* const* d_in, const int* in_sizes, int n_in, void* d_out, int out_size, void* d_ws, size_t ws_size, hipStream_t stream) {
    static int grid = 0;
    if (grid == 0) {
        if (n_in != 22 || out_size != M_TOK * DM || ws_size < WS_END) { fprintf(stderr, "kernel_launch: unexpected shapes (n_in %d, out %d, ws %zu, need %zu)\n", n_in, out_size, ws_size, (size_t)WS_END); grid = -1; return; }
        int dev = 0, cus = 0, per_cu = 0;
        (void)hipGetDevice(&dev); (void)hipDeviceGetAttribute(&cus, hipDeviceAttributeMultiprocessorCount, dev);
        (void)hipFuncSetAttribute((const void*)fwd_kernel<true>, hipFuncAttributeMaxDynamicSharedMemorySize, LDS_BYTES);
        (void)hipFuncSetAttribute((const void*)fwd_kernel<false>, hipFuncAttributeMaxDynamicSharedMemorySize, LDS_BYTES);
        (void)hipOccupancyMaxActiveBlocksPerMultiprocessor(&per_cu, (const void*)fwd_kernel<true>, 512, LDS_BYTES);
        if (per_cu < 1) per_cu = 1;
        (void)hipGetLastError();
        grid = cus * per_cu; if (grid > 256) grid = 256; if (grid < 1) grid = 256;
    }
    if (grid < 0) return;
    Params p{};
    for (int i = 0; i < 22; ++i) p.in[i] = (const float*)d_in[i];
    p.out = (float*)d_out; p.ws = (unsigned char*)d_ws;
#if MK_COOP
    p.ph_lo = 0; p.ph_hi = N_PHASES;
    void* args[] = {&p};
    hipError_t e = hipLaunchCooperativeKernel((const void*)fwd_kernel<true>, dim3(grid), dim3(512), args, LDS_BYTES, stream);
    if (e != hipSuccess) fprintf(stderr, "cooperative launch failed: %s (grid %d)\n", hipGetErrorString(e), grid);
#else
    for (int ph = 0; ph < N_PHASES; ++ph) {
        p.ph_lo = ph; p.ph_hi = ph + 1;
        hipLaunchKernelGGL(fwd_kernel<false>, dim3(grid), dim3(512), LDS_BYTES, stream, p);
    }
#endif
}
```

```cpp
#include <hip/hip_runtime.h>
#include <hip/hip_cooperative_groups.h>
#include <cstdio>
#include <cstdint>
namespace cg = cooperative_groups;

#ifndef MK_COOP
#define MK_COOP 1
#endif

#ifndef PROBE_MASK
#define PROBE_MASK 0u
#endif
#define LAS __attribute__((address_space(3)))
typedef unsigned short bf16_t;
typedef short bf16x8 __attribute__((ext_vector_type(8)));
typedef short s16x4 __attribute__((ext_vector_type(4)));
typedef float f32x4 __attribute__((ext_vector_type(4)));
typedef unsigned u32x4 __attribute__((ext_vector_type(4)));
typedef unsigned u32x2 __attribute__((ext_vector_type(2)));

constexpr int M_TOK = 49152, DM = 2048, SSMW = 1024, QKVW = 4608, GATEW = 4096, DFF = 8192;
constexpr int NCHUNK = M_TOK / 16;
constexpr int FF_ROWS = 24576, N_FFC = 2;
constexpr int N_PHASES = 10 + 2 * N_FFC + 1;
constexpr int LDS_BYTES = 131072 + 16;

constexpr size_t WS_ASSM = 0;
constexpr size_t WS_QKV = 201326592;
constexpr size_t WS_GATES = WS_QKV + 452984832;
constexpr size_t WS_LSE = WS_GATES + 402653184;
constexpr size_t WS_BIAS = WS_LSE + 2359296;
constexpr size_t WS_BAR = WS_BIAS + 8192;
constexpr size_t WS_END = WS_BAR + 16384;
constexpr size_t DO_WIN = 0, DO_WGLU = 39845888, DO_WBS = 41943040, DO_WBA = 46137344, DO_WOUT = 48234496, DO_WFF1 = 56623104, DO_WFF2 = 90177536;
constexpr size_t DO_BTY = 123731968;
constexpr size_t DO_BTS = 140509184;
constexpr size_t DO_XN = 148897792;
constexpr size_t DO_YATT = 350224384;

typedef __bf16 bf16x2_t __attribute__((ext_vector_type(2)));
typedef float f32x2_t __attribute__((ext_vector_type(2)));
__device__ __forceinline__ unsigned cvt_pk_bf16(float lo, float hi) { const bf16x2_t r = __builtin_convertvector((f32x2_t){lo, hi}, bf16x2_t); return __builtin_bit_cast(unsigned, r); }
__device__ __forceinline__ bf16_t f2bf(float f) { unsigned u = __float_as_uint(f); u += 0x7FFFu + ((u >> 16) & 1u); return (bf16_t)(u >> 16); }
__device__ __forceinline__ float bflo(unsigned w) { return __uint_as_float(w << 16); }
__device__ __forceinline__ float bfhi(unsigned w) { return __uint_as_float(w & 0xffff0000u); }
__device__ __forceinline__ void unpack8(const u32x4 w, f32x4& a, f32x4& b) { a = (f32x4){bflo(w.x), bfhi(w.x), bflo(w.y), bfhi(w.y)}; b = (f32x4){bflo(w.z), bfhi(w.z), bflo(w.w), bfhi(w.w)}; }
__device__ __forceinline__ u32x4 pack8(const f32x4 a, const f32x4 b) { u32x4 w; w.x = cvt_pk_bf16(a[0], a[1]); w.y = cvt_pk_bf16(a[2], a[3]); w.z = cvt_pk_bf16(b[0], b[1]); w.w = cvt_pk_bf16(b[2], b[3]); return w; }
__device__ __forceinline__ float sigmoidf_(float x) { return __builtin_amdgcn_rcpf(1.0f + __builtin_amdgcn_exp2f(-1.4426950408889634f * x)); }
__device__ __forceinline__ float gelu_tanh(float x) { const float y = 0.7978845608028654f * (x + 0.044715f * x * x * x); return x * __builtin_amdgcn_rcpf(1.0f + __builtin_amdgcn_exp2f(-2.8853900817779268f * y)); }

__device__ __forceinline__ int ltid() { int t = threadIdx.x; asm volatile("" : "+v"(t)); return t; }
__device__ __forceinline__ size_t opaque_zero() { size_t z = 0; asm volatile("" : "+s"(z)); return z; }
template <class T> __device__ __forceinline__ T* lptr(T* p) { return (T*)((unsigned char*)p + opaque_zero()); }
namespace pg8 {
constexpr int BM = 256, BK = 64, HALF = 128, HTB = HALF * BK * 2, NXCD = 8, WGM = 4;
__device__ __forceinline__ int lds_byte(int r, int c) { const int st = (r >> 4) * 2 + (c >> 5), rr = r & 15, cc = c & 31, ob = rr * 64 + cc * 2; return st * 1024 + (ob ^ (((ob >> 9) & 1) << 5)); }
__device__ __forceinline__ void stage_rc(int b, int& R, int& C) { const int st = b / 1024, sb = b % 1024, swz = sb ^ (((sb >> 9) & 1) << 5); R = (st >> 1) * 16 + swz / 64; C = (st & 1) * 32 + (swz % 64) / 2; }
__device__ __forceinline__ int perm32(int rho) { const int n = rho >> 4, i = rho & 15; return 8 * (i >> 2) + 4 * n + (i & 3); }

struct Unit { int pm, pn; };
struct GemmD { const bf16_t* A; const bf16_t* Bt; int lda, ldb, K; };

struct Sched {
    int nM, nN, nwg, G, c, ssm;
    __device__ __forceinline__ bool next(int i, Unit& u) const {
        const long L = (long)i * G + c; if (L >= nwg) return false;
        if (ssm) { u.pm = (int)L; u.pn = (int)L / 12; return true; }
        int wgid = (int)L; { const int q = nwg / NXCD, r = nwg % NXCD, xcd = wgid % NXCD, off = wgid / NXCD; wgid = (xcd < r ? xcd * (q + 1) : r * (q + 1) + (xcd - r) * q) + off; }
        const int nig = WGM * nN, gid = wgid / nig, fm = gid * WGM, gsz = (nM - fm) < WGM ? (nM - fm) : WGM;
        u.pm = fm + ((wgid % nig) % gsz); u.pn = (wgid % nig) / gsz; return true;
    }
};

enum { EM_INPROJ = 0, EM_SSM_S, EM_SSM_Y, EM_GLU, EM_BR1, EM_BR2, EM_OUT, EM_FF1, EM_FF2 };
struct Epi {
    int mode; unsigned char* ws; unsigned char* dob; const float* bglu; const float* x0; const float* x1; size_t hoff;
};
struct EpiP { bf16_t* assm; bf16_t* qkv; bf16_t* gates; bf16_t* S; bf16_t* z; const float* bglu; bf16_t* yssm; bf16_t* mixed; const float* x0; const float* x1; bf16_t* hb; bf16_t* hfin; bf16_t* act; };

template <int MODE>
__device__ __forceinline__ void epi_body(const Epi& E0, const f32x4 (&acc)[2][2][4][2], const Unit& u, int wr, int wc, int fr, int fq) {
    asm volatile("" : "+v"(fr), "+v"(fq));
    unsigned char* ws = lptr(E0.ws); unsigned char* dob = lptr(E0.dob);
    EpiP E;
    E.assm = (bf16_t*)(ws + WS_ASSM); E.qkv = (bf16_t*)(ws + WS_QKV); E.gates = (bf16_t*)(ws + WS_GATES); E.S = (bf16_t*)(dob + DO_XN); E.z = (bf16_t*)(dob + DO_XN);
    E.bglu = E0.bglu; E.yssm = E.z + (size_t)M_TOK * SSMW; E.mixed = (bf16_t*)(ws + WS_QKV); E.x0 = E0.x0; E.x1 = E0.x1; E.hb = (bf16_t*)(ws + WS_GATES) + E0.hoff; E.hfin = (bf16_t*)(ws + WS_GATES) + (size_t)M_TOK * DM + E0.hoff; E.act = (bf16_t*)(ws + WS_QKV);
    const int row0 = u.pm * BM + wr * 64 + fr, cl0 = wc * 32 + 8 * fq;
#pragma unroll
    for (int ai = 0; ai < 2; ++ai)
#pragma unroll
        for (int m = 0; m < 4; ++m) {
            const int r = row0 + ai * HALF + m * 16;
#pragma unroll
            for (int bj = 0; bj < 2; ++bj) {
                const int cl = cl0 + bj * HALF;
                f32x4 v0 = acc[ai][bj][m][0], v1 = acc[ai][bj][m][1];
                if constexpr (MODE == EM_INPROJ) {
                    if (u.pn < 4) {
                        const int col = u.pn * 256 + cl, g = col >> 4, cc = col & 15, chunk = r >> 4, t = r & 15;
                        *(u32x4*)(E.assm + ((size_t)(g * NCHUNK + chunk) * 512 + t * 16 + cc)) = pack8(v0, v1);
                    } else if (u.pn < 22) {
                        const int hidx = (u.pn - 4) * 2 + bj, tensor = hidx / 12, head = hidx - tensor * 12, dcol = cl & 127, dsh = (head >> 2) * 2;
                        int sbase, lsh; if (r < 32768) { sbase = r & ~8191; lsh = 13; } else { sbase = 32768; lsh = 14; }
                        const int local = r - sbase, perm = sbase + ((local & ((1 << dsh) - 1)) << (lsh - dsh)) + (local >> dsh);
                        *(u32x4*)(E.qkv + ((size_t)hidx * M_TOK + perm) * 128 + dcol) = pack8(v0, v1);
                    } else {
#pragma unroll
                        for (int j = 0; j < 4; ++j) { v0[j] = sigmoidf_(v0[j]); v1[j] = sigmoidf_(v1[j]); }
                        *(u32x4*)(E.gates + (size_t)r * GATEW + (u.pn - 22) * 256 + cl) = pack8(v0, v1);
                    }
                } else if constexpr (MODE == EM_SSM_S) {
                    *(u32x4*)(E.S + (size_t)r * 256 + cl) = pack8(v0, v1);
                } else if constexpr (MODE == EM_SSM_Y) {
                    const int g = u.pm / 12, chunk = r - g * NCHUNK, t = cl >> 4, cc = cl & 15, tok = chunk * 16 + t;
#pragma unroll
                    for (int j = 0; j < 4; ++j) { v0[j] = gelu_tanh(v0[j]); v1[j] = gelu_tanh(v1[j]); }
                    *(u32x4*)(E.z + (size_t)tok * SSMW + g * 16 + cc) = pack8(v0, v1);
                } else if constexpr (MODE == EM_GLU) {
                    const int c = u.pn * 256 + cl; const size_t off = (size_t)r * SSMW + c;
                    f32x4 z0, z1; unpack8(*(const u32x4*)(E.z + off), z0, z1);
                    const f32x4 b0 = *(const f32x4*)(E.bglu + c), b1 = *(const f32x4*)(E.bglu + c + 4);
#pragma unroll
                    for (int j = 0; j < 4; ++j) { v0[j] = z0[j] * sigmoidf_(v0[j] + b0[j]); v1[j] = z1[j] * sigmoidf_(v1[j] + b1[j]); }
                    *(u32x4*)(E.yssm + off) = pack8(v0, v1);
                } else if constexpr (MODE == EM_BR1) {
                    const int c = u.pn * 256 + cl;
                    f32x4 g0, g1; unpack8(*(const u32x4*)(E.gates + (size_t)r * GATEW + c), g0, g1);
                    *(u32x4*)(E.mixed + (size_t)r * DM + c) = pack8(g0 * v0, g1 * v1);
                } else if constexpr (MODE == EM_BR2) {
                    const int c = u.pn * 256 + cl;
                    f32x4 g0, g1, m0, m1; unpack8(*(const u32x4*)(E.gates + (size_t)r * GATEW + DM + c), g0, g1);
                    bf16_t* mp = E.mixed + (size_t)r * DM + c; unpack8(*(const u32x4*)mp, m0, m1);
                    *(u32x4*)mp = pack8(m0 + g0 * v0, m1 + g1 * v1);
                } else if constexpr (MODE == EM_OUT) {
                    const int c = u.pn * 256 + cl;
                    const float* xr = (r < 32768 ? E.x0 + (size_t)r * DM : E.x1 + (size_t)(r - 32768) * DM) + c;
                    *(u32x4*)(E.hb + (size_t)r * DM + c) = pack8(*(const f32x4*)xr + v0, *(const f32x4*)(xr + 4) + v1);
                } else if constexpr (MODE == EM_FF1) {
                    const int c = u.pn * 256 + cl;
#pragma unroll
                    for (int j = 0; j < 4; ++j) { const float a = fmaxf(v0[j], 0.f), b = fmaxf(v1[j], 0.f); v0[j] = a * a; v1[j] = b * b; }
                    *(u32x4*)(E.act + (size_t)r * DFF + c) = pack8(v0, v1);
                } else if constexpr (MODE == EM_FF2) {
                    const int c = u.pn * 256 + cl;
                    f32x4 h0, h1; unpack8(*(const u32x4*)(E.hb + (size_t)r * DM + c), h0, h1);
                    *(u32x4*)(E.hfin + (size_t)r * DM + c) = pack8(h0 + v0, h1 + v1);
                }
            }
        }
}
__device__ __forceinline__ void epi_run(const Epi& E, const f32x4 (&acc)[2][2][4][2], const Unit& u, int wr, int wc, int fr, int fq) {
    switch (E.mode) {
        case EM_INPROJ: epi_body<EM_INPROJ>(E, acc, u, wr, wc, fr, fq); break;
        case EM_SSM_S: epi_body<EM_SSM_S>(E, acc, u, wr, wc, fr, fq); break;
        case EM_SSM_Y: epi_body<EM_SSM_Y>(E, acc, u, wr, wc, fr, fq); break;
        case EM_GLU: epi_body<EM_GLU>(E, acc, u, wr, wc, fr, fq); break;
        case EM_BR1: epi_body<EM_BR1>(E, acc, u, wr, wc, fr, fq); break;
        case EM_BR2: epi_body<EM_BR2>(E, acc, u, wr, wc, fr, fq); break;
        case EM_OUT: epi_body<EM_OUT>(E, acc, u, wr, wc, fr, fq); break;
        case EM_FF1: epi_body<EM_FF1>(E, acc, u, wr, wc, fr, fq); break;
        default: epi_body<EM_FF2>(E, acc, u, wr, wc, fr, fq); break;
    }
}

__device__ __forceinline__ void gemm_phase(LAS unsigned char* lds, const GemmD g, const Sched& S, const Epi& E) {
    const int tid = ltid(), wid = __builtin_amdgcn_readfirstlane(tid >> 6), lane = tid & 63, wr = wid >> 2, wc = wid & 3, fr = lane & 15, fq = lane >> 4;
    const int K = g.K, nt = K / BK;
    unsigned voffA[2], voffB[2];
#pragma unroll
    for (int i = 0; i < 2; ++i) { int R, C; stage_rc(tid * 16 + i * 8192, R, C); const int Rb = (R & ~31) + perm32(R & 31);
        voffA[i] = (unsigned)(R * g.lda + C) * 2u; voffB[i] = (unsigned)(Rb * g.ldb + C) * 2u; }
    const size_t kstep = (size_t)(BK * 2);
    const size_t hstepA = (size_t)HALF * g.lda * 2, tstepA = 2 * hstepA;
    const size_t hstepB = (size_t)HALF * g.ldb * 2, tstepB = 2 * hstepB;
    const unsigned ldsw = (unsigned)wid * 1024u;
    const int aoff = lds_byte(wr * 64 + fr, fq * 8), boff = lds_byte(wc * 32 + fr, fq * 8);
#define PG8_SA(b, h) (((b) * 2 + (h)) * HTB)
#define PG8_SB(b, h) ((4 + (b) * 2 + (h)) * HTB)
#define PG8_STAGE(bufoff, gbase, voff) do { _Pragma("unroll") for (int _i = 0; _i < 2; ++_i) \
        __builtin_amdgcn_global_load_lds((const unsigned*)((const char*)(gbase) + (voff)[_i]), (LAS unsigned*)(lds + (bufoff) + ldsw + _i * 8192), 16, 0, 0); } while (0)
#define PG8_LDA(dst, b, h) do { _Pragma("unroll") for (int m = 0; m < 4; ++m) _Pragma("unroll") for (int k = 0; k < 2; ++k) dst[m][k] = *(const LAS bf16x8*)(lds + PG8_SA(b, h) + aoff + m * 2048 + k * 1024); } while (0)
#define PG8_LDB(dst, b, h) do { _Pragma("unroll") for (int n = 0; n < 2; ++n) _Pragma("unroll") for (int k = 0; k < 2; ++k) dst[n][k] = *(const LAS bf16x8*)(lds + PG8_SB(b, h) + boff + n * 2048 + k * 1024); } while (0)
#define PG8_MMA(ai, bj, At, Bt) do { __builtin_amdgcn_s_setprio(1); _Pragma("unroll") for (int m = 0; m < 4; ++m) _Pragma("unroll") for (int n = 0; n < 2; ++n) _Pragma("unroll") for (int k = 0; k < 2; ++k) \
        acc[ai][bj][m][n] = __builtin_amdgcn_mfma_f32_16x16x32_bf16(Bt[n][k], At[m][k], acc[ai][bj][m][n], 0, 0, 0); __builtin_amdgcn_s_setprio(0); } while (0)
#define PG8_WAIT_V(n) asm volatile("s_waitcnt vmcnt(" #n ")" ::: "memory")
#define PG8_WAIT_L(n) asm volatile("s_waitcnt lgkmcnt(" #n ")" ::: "memory")
#define PG8_BAR __builtin_amdgcn_s_barrier()
#define PG8_SCHED __builtin_amdgcn_sched_barrier(0)
    Unit cur, nxt; int ui = 0;
    if (!S.next(0, cur)) return;
    f32x4 acc[2][2][4][2];
#pragma unroll
    for (int a = 0; a < 2; ++a)
#pragma unroll
        for (int b = 0; b < 2; ++b)
#pragma unroll
            for (int m = 0; m < 4; ++m)
#pragma unroll
                for (int n = 0; n < 2; ++n) acc[a][b][m][n] = (f32x4){0.f, 0.f, 0.f, 0.f};
    bf16x8 At[4][2], B0[2][2], B1[2][2];
    const char* cA = (const char*)g.A + (size_t)cur.pm * tstepA; const char* cB = (const char*)g.Bt + (size_t)cur.pn * tstepB;
    PG8_STAGE(PG8_SB(0, 0), cB, voffB); PG8_STAGE(PG8_SB(0, 1), cB + hstepB, voffB); PG8_STAGE(PG8_SA(0, 0), cA, voffA); PG8_STAGE(PG8_SA(0, 1), cA + hstepA, voffA);
    if (wr == 1) PG8_BAR;
    PG8_WAIT_V(2); PG8_BAR;
    PG8_STAGE(PG8_SB(1, 0), cB + kstep, voffB); PG8_STAGE(PG8_SA(1, 0), cA + kstep, voffA); PG8_STAGE(PG8_SB(1, 1), cB + hstepB + kstep, voffB);
    PG8_WAIT_V(6); PG8_BAR;
    for (;;) {
        const bool has_next = S.next(ui + 1, nxt);
        const char* nA = has_next ? (const char*)g.A + (size_t)nxt.pm * tstepA : cA; const char* nB = has_next ? (const char*)g.Bt + (size_t)nxt.pn * tstepB : cB;
        for (int t = 0; t < nt; t += 2) {
            const bool last = (t == nt - 2);
            const char* a1 = cA + (size_t)(t + 1) * kstep;
            const char* a2 = last ? nA : cA + (size_t)(t + 2) * kstep; const char* b2 = last ? nB : cB + (size_t)(t + 2) * kstep;
            const char* a3 = a2 + kstep; const char* b3 = b2 + kstep;
            PG8_LDB(B0, 0, 0); PG8_LDB(B1, 0, 1); PG8_SCHED; PG8_LDA(At, 0, 0); PG8_STAGE(PG8_SA(1, 1), a1 + hstepA, voffA);
            PG8_WAIT_V(8); PG8_WAIT_L(0); PG8_BAR; PG8_MMA(0, 0, At, B0); PG8_MMA(0, 1, At, B1); PG8_BAR; PG8_SCHED;
            PG8_LDA(At, 0, 1); PG8_STAGE(PG8_SB(0, 0), b2, voffB); PG8_STAGE(PG8_SB(0, 1), b2 + hstepB, voffB); PG8_STAGE(PG8_SA(0, 0), a2, voffA);
            PG8_WAIT_V(8); PG8_WAIT_L(0); PG8_BAR; PG8_MMA(1, 0, At, B0); PG8_MMA(1, 1, At, B1); PG8_BAR; PG8_SCHED;
            PG8_LDB(B0, 1, 0); PG8_LDB(B1, 1, 1); PG8_SCHED; PG8_LDA(At, 1, 0); PG8_STAGE(PG8_SA(0, 1), a2 + hstepA, voffA);
            PG8_WAIT_V(8); PG8_WAIT_L(0); PG8_BAR; PG8_MMA(0, 0, At, B0); PG8_MMA(0, 1, At, B1); PG8_BAR; PG8_SCHED;
            PG8_LDA(At, 1, 1); PG8_STAGE(PG8_SB(1, 0), b3, voffB); PG8_STAGE(PG8_SB(1, 1), b3 + hstepB, voffB); PG8_STAGE(PG8_SA(1, 0), a3, voffA);
            PG8_WAIT_V(8); PG8_WAIT_L(0); PG8_BAR; PG8_MMA(1, 0, At, B0); PG8_MMA(1, 1, At, B1); PG8_BAR; PG8_SCHED;
        }
        if (wr == 0) PG8_BAR;
        epi_run(E, acc, cur, wr, wc, fr, fq);
        if (!has_next) break;
#pragma unroll
        for (int a = 0; a < 2; ++a)
#pragma unroll
            for (int b = 0; b < 2; ++b)
#pragma unroll
                for (int m = 0; m < 4; ++m)
#pragma unroll
                    for (int n = 0; n < 2; ++n) acc[a][b][m][n] = (f32x4){0.f, 0.f, 0.f, 0.f};
        cur = nxt; cA = nA; cB = nB; ++ui;
        if (wr == 1) PG8_BAR;
    }
    PG8_WAIT_V(0);
    PG8_BAR;
#undef PG8_SA
#undef PG8_SB
#undef PG8_STAGE
#undef PG8_LDA
#undef PG8_LDB
#undef PG8_MMA
#undef PG8_WAIT_V
#undef PG8_WAIT_L
#undef PG8_BAR
#undef PG8_SCHED
}
}

#define XB_TMO      128
#define XB_XCNT(j)  (256  + 64 * (j))
#define XB_XSUB(j)  (1280 + 64 * (j))
#define XB_XGEN(j)  (2304 + 64 * (j))
#define XB_TOP      3328
#define XB_TOPGEN   3392
#define XCD_BAR_WORDS 3456
#define XB_SPIN_CAP (1u << 22)
__device__ __forceinline__ unsigned xb_ld(unsigned* p)              { return __hip_atomic_load(p, __ATOMIC_RELAXED, __HIP_MEMORY_SCOPE_AGENT); }
__device__ __forceinline__ unsigned xb_add(unsigned* p, unsigned v) { return __hip_atomic_fetch_add(p, v, __ATOMIC_RELAXED, __HIP_MEMORY_SCOPE_AGENT); }
__device__ __forceinline__ unsigned xb_xcc_id() { return (unsigned)__builtin_amdgcn_s_getreg((3 << 11) | 20) & 0xFu; }
#define XB_SPIN(cond, bar) do { unsigned _sp = 0; while (cond) { __builtin_amdgcn_s_sleep(1); \
    if ((++_sp & 255u) == 0u) { if (xb_ld(&(bar)[XB_TMO])) break; if (_sp > XB_SPIN_CAP) { atomicAdd(&(bar)[XB_TMO], 1u); break; } } } } while (0)
struct XcdBarrier { unsigned* bar; unsigned x; volatile LAS unsigned* st; };
__device__ __forceinline__ XcdBarrier xcd_barrier_post(unsigned* bar, volatile LAS unsigned* st) {
    XcdBarrier b; b.bar = bar; b.x = xb_xcc_id(); b.st = st;
    if (threadIdx.x == 0) (void)xb_add(&bar[XB_XCNT(b.x)], 1u);
    return b;
}
__device__ __forceinline__ void xcd_barrier_complete(unsigned* bar, unsigned x, unsigned& nloc, unsigned& nx) {
    const unsigned G = gridDim.x * gridDim.y * gridDim.z;
    unsigned sum, cnt, mine, sp = 0u;
    for (;;) {
        sum = 0u; cnt = 0u; mine = 0u;
#pragma unroll
        for (unsigned j = 0; j < 16; ++j) { const unsigned c = xb_ld(&bar[XB_XCNT(j)]); sum += c; cnt += (c > 0u) ? 1u : 0u; mine = (j == x) ? c : mine; }
        if (sum == G) break;
        __builtin_amdgcn_s_sleep(1);
        if ((++sp & 255u) == 0u) { if (xb_ld(&bar[XB_TMO])) break; if (sp > XB_SPIN_CAP) { atomicAdd(&bar[XB_TMO], 1u); break; } }
    }
    nloc = mine > 0u ? mine : 1u; nx = cnt > 0u ? cnt : 1u;
}
__device__ __forceinline__ void xcd_barrier(const XcdBarrier& b) {
    asm volatile("s_waitcnt vmcnt(0)" ::: "memory");
    __syncthreads();
    if (threadIdx.x == 0) {
        unsigned* bar = b.bar;
        __builtin_amdgcn_s_waitcnt(0);
        unsigned nloc = b.st[0], nx = b.st[1];
        if (nloc == 0u) { xcd_barrier_complete(bar, b.x, nloc, nx); b.st[0] = nloc; b.st[1] = nx; }
        const unsigned old = xb_add(&bar[XB_XSUB(b.x)], 1u);
        const unsigned gen = old / nloc;
        if (old + 1u == (gen + 1u) * nloc) {
            __builtin_amdgcn_fence(__ATOMIC_RELEASE, "agent");
            asm volatile("s_waitcnt vmcnt(0)" ::: "memory");
            const unsigned og = xb_add(&bar[XB_TOP], 1u);
            const unsigned tg = og / nx;
            if (og + 1u == (tg + 1u) * nx) xb_add(&bar[XB_TOPGEN], 1u);
            else XB_SPIN(xb_ld(&bar[XB_TOPGEN]) == tg, bar);
            __builtin_amdgcn_fence(__ATOMIC_ACQUIRE, "agent");
            xb_add(&bar[XB_XGEN(b.x)], 1u);
            asm volatile("s_waitcnt vmcnt(0)" ::: "memory");
        } else {
            XB_SPIN(xb_ld(&bar[XB_XGEN(b.x)]) == gen, bar);
            __builtin_amdgcn_fence(__ATOMIC_ACQUIRE, "agent");
            asm volatile("s_waitcnt vmcnt(0)" ::: "memory");
        }
    }
    __syncthreads();
}

struct Params { const float* in[22]; float* out; unsigned char* ws; int ph_lo, ph_hi; };

__device__ __forceinline__ void ssm_prep(LAS unsigned char* lds, const Params& p, int g) {
    const float* a_re = p.in[4]; const float* a_im = p.in[5]; const float* log_dt = p.in[6];
    const float* b_re = p.in[7]; const float* b_im = p.in[8]; const float* c_re = p.in[9]; const float* c_im = p.in[10]; const float* dskip = p.in[11];
    LAS float* apow = (LAS float*)lds;
    LAS float* Bb = apow + 2 * 17 * 64 * 2;
    LAS float* Cc = Bb + 2 * 64 * 16 * 2;
    LAS float* Kt = Cc + 2 * 16 * 64 * 2;
    const int tid = ltid();
    for (int idx = tid; idx < 2 * 17 * 64; idx += 512) {
        const int dir = idx / (17 * 64), j = (idx / 64) % 17, pp = idx % 64;
        const float are = a_re[(dir * 64 + g) * 64 + pp], aim = a_im[(dir * 64 + g) * 64 + pp], dt = expf(log_dt[dir * 64 + g]);
        const float x = are * dt * (float)j, y = aim * dt * (float)j; const float mag = expf(x); float s, c; sincosf(y, &s, &c);
        apow[idx * 2] = mag * c; apow[idx * 2 + 1] = mag * s;
    }
    for (int idx = tid; idx < 2 * 64 * 16; idx += 512) {
        const int dir = idx / 1024, pp = (idx / 16) % 64, c = idx % 16;
        const float are = a_re[(dir * 64 + g) * 64 + pp], aim = a_im[(dir * 64 + g) * 64 + pp], dt = expf(log_dt[dir * 64 + g]);
        const float x = are * dt, y = aim * dt; const float ex1 = expm1f(x); float sy, cy; sincosf(y, &sy, &cy); const float sh = sinf(0.5f * y);
        const float nr = ex1 * cy - 2.0f * sh * sh, ni = (ex1 + 1.0f) * sy;
        const float den = are * are + aim * aim; const float qr = (nr * are + ni * aim) / den, qi = (ni * are - nr * aim) / den;
        const float br = b_re[((dir * 64 + g) * 64 + pp) * 16 + c], bi = b_im[((dir * 64 + g) * 64 + pp) * 16 + c];
        Bb[idx * 2] = qr * br - qi * bi; Bb[idx * 2 + 1] = qr * bi + qi * br;
    }
    for (int idx = tid; idx < 2 * 16 * 64; idx += 512) {
        const int dir = idx / 1024, c = (idx / 64) % 16, pp = idx % 64;
        Cc[idx * 2] = c_re[((dir * 64 + g) * 16 + c) * 64 + pp]; Cc[idx * 2 + 1] = c_im[((dir * 64 + g) * 16 + c) * 64 + pp];
    }
    __syncthreads();
    for (int idx = tid; idx < 8192; idx += 512) {
        const int dir = idx >> 12, j = (idx >> 8) & 15, c = (idx >> 4) & 15, c2 = idx & 15;
        float acc = 0.f;
        for (int pp = 0; pp < 64; ++pp) {
            const float ar = apow[((dir * 17 + j) * 64 + pp) * 2], ai = apow[((dir * 17 + j) * 64 + pp) * 2 + 1];
            const float cr = Cc[((dir * 16 + c) * 64 + pp) * 2], ci = Cc[((dir * 16 + c) * 64 + pp) * 2 + 1];
            const float br = Bb[((dir * 64 + pp) * 16 + c2) * 2], bi = Bb[((dir * 64 + pp) * 16 + c2) * 2 + 1];
            const float wr = cr * ar - ci * ai, wi = cr * ai + ci * ar;
            acc += wr * br - wi * bi;
        }
        Kt[idx] = acc;
    }
    bf16_t* bty = (bf16_t*)((unsigned char*)p.out + DO_BTY) + (size_t)g * 256 * 512;
    bf16_t* bts = (bf16_t*)((unsigned char*)p.out + DO_BTS) + (size_t)g * 256 * 256;
    for (int idx = tid; idx < 65536; idx += 512) {
        const int n = idx >> 8, kk = idx & 255, t = n >> 4, c = n & 15, dir = kk >> 7, reim = (kk >> 6) & 1, pp = kk & 63;
        const int j = dir == 0 ? t + 1 : 16 - t;
        const float ar = apow[((dir * 17 + j) * 64 + pp) * 2], ai = apow[((dir * 17 + j) * 64 + pp) * 2 + 1];
        const float cr = Cc[((dir * 16 + c) * 64 + pp) * 2], ci = Cc[((dir * 16 + c) * 64 + pp) * 2 + 1];
        const float wr = cr * ar - ci * ai, wi = cr * ai + ci * ar;
        bty[n * 512 + 256 + kk] = f2bf(reim == 0 ? wr : -wi);
    }
    for (int idx = tid; idx < 65536; idx += 512) {
        const int n = idx >> 8, kk = idx & 255, dir = n >> 7, reim = (n >> 6) & 1, pp = n & 63, s = kk >> 4, c2 = kk & 15;
        const int j = dir == 0 ? 15 - s : s;
        const float ar = apow[((dir * 17 + j) * 64 + pp) * 2], ai = apow[((dir * 17 + j) * 64 + pp) * 2 + 1];
        const float br = Bb[((dir * 64 + pp) * 16 + c2) * 2], bi = Bb[((dir * 64 + pp) * 16 + c2) * 2 + 1];
        const float wr = ar * br - ai * bi, wi = ar * bi + ai * br;
        bts[n * 256 + kk] = f2bf(reim == 0 ? wr : wi);
    }
    __syncthreads();
    for (int idx = tid; idx < 65536; idx += 512) {
        const int n = idx >> 8, kk = idx & 255, t = n >> 4, c = n & 15, s = kk >> 4, c2 = kk & 15;
        float v = 0.f;
        if (s <= t) v += Kt[(((t - s)) * 16 + c) * 16 + c2];
        if (s >= t) v += Kt[((16 + (s - t)) * 16 + c) * 16 + c2];
        if (s == t && c == c2) v += dskip[g * 16 + c];
        bty[n * 512 + kk] = f2bf(v);
    }
    __syncthreads();
}

__device__ __forceinline__ int t5_bucket(int rel) {
    const int ret = rel > 0 ? 16 : 0; const int n = rel < 0 ? -rel : rel;
    if (n < 8) return ret + n;
    int large = 8 + (int)(logf((float)n / 8.0f) / 4.852030263919617f * 8.0f);
    large = large < 15 ? large : 15;
    return ret + large;
}

constexpr int RMS_NR = 4;
template <bool OUT_BF16>
__device__ __forceinline__ void rms_rows(const float* s0, const float* s1, const float* gam, void* dst, int G) {
    const int tid_ = ltid(); const int lane = tid_ & 63, gw = blockIdx.x * 8 + (tid_ >> 6), nw = G * 8;
    for (int r0 = gw; r0 < M_TOK; r0 += RMS_NR * nw) {
        f32x4 v[RMS_NR][8]; float ss[RMS_NR];
#pragma unroll
        for (int q = 0; q < RMS_NR; ++q) {
            const int r = r0 + q * nw, rc = r < M_TOK ? r : r0;
            const float* src = (s1 != nullptr && rc >= 32768) ? s1 + (size_t)(rc - 32768) * DM : s0 + (size_t)rc * DM;
#pragma unroll
            for (int j = 0; j < 8; ++j) v[q][j] = *(const f32x4*)(src + (j * 64 + lane) * 4);
        }
#pragma unroll
        for (int q = 0; q < RMS_NR; ++q) { float a = 0.f;
#pragma unroll
            for (int j = 0; j < 8; ++j) a += v[q][j][0] * v[q][j][0] + v[q][j][1] * v[q][j][1] + v[q][j][2] * v[q][j][2] + v[q][j][3] * v[q][j][3];
#pragma unroll
            for (int o = 32; o >= 1; o >>= 1) a += __shfl_xor(a, o);
            ss[q] = rsqrtf(a * (1.0f / DM) + 1e-6f); }
#pragma unroll
        for (int j = 0; j < 8; ++j) {
            const f32x4 gg = *(const f32x4*)(gam + (j * 64 + lane) * 4);
#pragma unroll
            for (int q = 0; q < RMS_NR; ++q) {
                const int r = r0 + q * nw; if (r >= M_TOK) continue;
                const f32x4 y = v[q][j] * ss[q] * gg;
                if constexpr (OUT_BF16) { u32x2 w; w.x = cvt_pk_bf16(y[0], y[1]); w.y = cvt_pk_bf16(y[2], y[3]); *(u32x2*)((bf16_t*)dst + (size_t)r * DM + (j * 64 + lane) * 4) = w; }
                else *(f32x4*)((float*)dst + (size_t)r * DM + (j * 64 + lane) * 4) = y;
            }
        }
    }
}

template <bool OUT_BF16>
__device__ __forceinline__ void rms_rows_b16(const bf16_t* src, const float* gam, void* dst, int G) {
    const int tid_ = ltid(); const int lane = tid_ & 63, gw = blockIdx.x * 8 + (tid_ >> 6), nw = G * 8;
    for (int r0 = gw; r0 < M_TOK; r0 += RMS_NR * nw) {
        u32x4 v[RMS_NR][4]; float ss[RMS_NR];
#pragma unroll
        for (int q = 0; q < RMS_NR; ++q) {
            const int r = r0 + q * nw, rc = r < M_TOK ? r : r0;
#pragma unroll
            for (int j = 0; j < 4; ++j) v[q][j] = *(const u32x4*)(src + (size_t)rc * DM + (j * 64 + lane) * 8);
        }
#pragma unroll
        for (int q = 0; q < RMS_NR; ++q) { float a = 0.f;
#pragma unroll
            for (int j = 0; j < 4; ++j) { f32x4 x0, x1; unpack8(v[q][j], x0, x1); a += (x0[0] * x0[0] + x0[1] * x0[1]) + (x0[2] * x0[2] + x0[3] * x0[3]) + (x1[0] * x1[0] + x1[1] * x1[1]) + (x1[2] * x1[2] + x1[3] * x1[3]); }
#pragma unroll
            for (int o = 32; o >= 1; o >>= 1) a += __shfl_xor(a, o);
            ss[q] = rsqrtf(a * (1.0f / DM) + 1e-6f); }
#pragma unroll
        for (int j = 0; j < 4; ++j) {
            const f32x4 g0 = *(const f32x4*)(gam + (j * 64 + lane) * 8), g1 = *(const f32x4*)(gam + (j * 64 + lane) * 8 + 4);
#pragma unroll
            for (int q = 0; q < RMS_NR; ++q) {
                const int r = r0 + q * nw; if (r >= M_TOK) continue;
                f32x4 x0, x1; unpack8(v[q][j], x0, x1);
                const f32x4 y0 = x0 * ss[q] * g0, y1 = x1 * ss[q] * g1;
                if constexpr (OUT_BF16) *(u32x4*)((bf16_t*)dst + (size_t)r * DM + (j * 64 + lane) * 8) = pack8(y0, y1);
                else { float* d = (float*)dst + (size_t)r * DM + (j * 64 + lane) * 8; *(f32x4*)d = y0; *(f32x4*)(d + 4) = y1; }
            }
        }
    }
}

__device__ __forceinline__ void prep_phase(LAS unsigned char* lds, const Params& p, int G) {
    const int tid = ltid();
    for (int g = blockIdx.x; g < 64; g += G) ssm_prep(lds, p, g);
    if ((int)blockIdx.x == G - 1) {
        float* bt = (float*)(p.ws + WS_BIAS); const float* rb = p.in[20];
        for (int idx = tid; idx < 12 * 129; idx += 512) { const int head = idx / 129, ri = idx % 129, d = 1 << (2 * (head >> 2));
            bt[head * 132 + ri] = rb[t5_bucket((ri - 64) * d) * 12 + head] * 1.4426950408889634f; }
    }
    {
        const float* srcs[7] = {p.in[3], p.in[12], p.in[14], p.in[15], p.in[16], p.in[18], p.in[19]};
        const size_t dofs[7] = {DO_WIN, DO_WGLU, DO_WBS, DO_WBA, DO_WOUT, DO_WFF1, DO_WFF2};
        const int Ks[7] = {2048, 1024, 1024, 512, 2048, 2048, 8192}, Ns[7] = {9728, 1024, 2048, 2048, 2048, 8192, 2048};
        LAS float* tl = (LAS float*)lds;
        int total = 0;
#pragma unroll
        for (int w = 0; w < 7; ++w) total += (Ks[w] / 64) * (Ns[w] / 64);
        const int tskew = G > 128 ? 64 : 0;
        for (int tile0 = (int)blockIdx.x - tskew; tile0 < total; tile0 += 2 * (G - tskew)) {
            if (tile0 < 0) break;
            float ld[2][8]; bf16_t* dsts[2]; int Kq[2], k0q[2], n0q[2]; bool okq[2];
#pragma unroll
            for (int q = 0; q < 2; ++q) {
                const int tile = tile0 + q * (G - tskew); okq[q] = tile < total;
                int w = 0, tt = okq[q] ? tile : tile0; const float* src = srcs[0]; size_t dof = dofs[0]; int K = Ks[0], N = Ns[0];
#pragma unroll
                for (int qq = 0; qq < 6; ++qq) { const int cnt = (Ks[qq] / 64) * (Ns[qq] / 64); if (w == qq && tt >= cnt) { tt -= cnt; w = qq + 1; src = srcs[qq + 1]; dof = dofs[qq + 1]; K = Ks[qq + 1]; N = Ns[qq + 1]; } }
                const int ntn = N / 64, k0 = (tt / ntn) * 64, n0 = (tt % ntn) * 64;
                dsts[q] = (bf16_t*)((unsigned char*)p.out + dof); Kq[q] = K; k0q[q] = k0; n0q[q] = n0;
                const int j = tid & 63, i0 = tid >> 6;
#pragma unroll
                for (int ii = 0; ii < 8; ++ii) { const int i = i0 + 8 * ii; ld[q][ii] = src[(size_t)(k0 + i) * N + n0 + j]; }
            }
#pragma unroll
            for (int q = 0; q < 2; ++q) { const int j = tid & 63, i0 = tid >> 6;
#pragma unroll
                for (int ii = 0; ii < 8; ++ii) { const int i = i0 + 8 * ii; tl[q * 64 * 65 + i * 65 + j] = ld[q][ii]; } }
            __syncthreads();
#pragma unroll
            for (int q = 0; q < 2; ++q) { if (!okq[q]) continue; const int kp = tid & 31, nn0 = tid >> 5;
#pragma unroll
                for (int jj = 0; jj < 4; ++jj) { const int nn = nn0 + 16 * jj;
                    *(unsigned*)(dsts[q] + (size_t)(n0q[q] + nn) * Kq[q] + k0q[q] + 2 * kp) = cvt_pk_bf16(tl[q * 64 * 65 + (2 * kp) * 65 + nn], tl[q * 64 * 65 + (2 * kp + 1) * 65 + nn]); } }
            __syncthreads();
        }
    }
    rms_rows<true>(p.in[0], p.in[1], p.in[2], (void*)((unsigned char*)p.out + DO_XN), G);
}

constexpr int VS_PITCH = 288, VS_ROWS = 208, VS_BYTES = VS_ROWS * VS_PITCH;
struct AttnItem { int head, dsh, r, pos0, seq_base, m, i0; };
__device__ __forceinline__ AttnItem attn_item(int it) {
    AttnItem a; a.head = it / 768; const int pb = it - a.head * 768, gi = a.head >> 2; a.dsh = gi * 2;
    const int p0 = pb * 64; int lsh; if (p0 < 32768) { a.seq_base = p0 & ~8191; lsh = 13; } else { a.seq_base = 32768; lsh = 14; }
    const int lm = lsh - a.dsh; a.m = 1 << lm; const int local = p0 - a.seq_base; a.r = local >> lm; a.i0 = local - (a.r << lm);
    a.pos0 = a.seq_base + (a.i0 << a.dsh); return a;
}
__device__ __forceinline__ int attn_pair(int j, int c, int G) {
    if ((G & 7) == 0 && (4608 % G) == 0) { const int per_xcd = 4608 / 8, wpx = G >> 3; return (c & 7) * per_xcd + j * wpx + (c >> 3); }
    return j * G + c;
}
__device__ __forceinline__ void attn_load_v(const AttnItem& a, const bf16_t* qkv, int ht, u32x4 (&vreg)[12]) {
#pragma unroll
    for (int pass = 0; pass < 12; ++pass) {
        const int row = pass * 16 + (ht >> 4), ch = ht & 15, ki = a.i0 - 64 + row;
        u32x4 val = (u32x4){0u, 0u, 0u, 0u};
        if (ki >= 0 && ki < a.m) val = *(const u32x4*)(qkv + ((size_t)(24 + a.head) * M_TOK + a.seq_base + a.r * a.m + ki) * 128 + ch * 8);
        vreg[pass] = val;
    }
}
template <bool EDGE>
__device__ __forceinline__ float attn_scores(f32x4 (&sa)[10], const LAS float* bsl, int dl, int kabs0, int m, float scale2) {
    float mx = -3.0e38f;
#pragma unroll
    for (int t9 = 0; t9 < 9; ++t9)
#pragma unroll
        for (int j = 0; j < 4; ++j) {
            bool valid = true;
            if (t9 == 0) valid = (j + dl >= 0);
            if (t9 == 8) valid = (j + dl <= 0);
            if (EDGE) { const int kabs = kabs0 + 16 * t9 + j; valid = valid && (kabs >= 0) && (kabs < m); }
            float sv = sa[t9][j] * scale2 + bsl[16 * t9 + j];
            sv = valid ? sv : -1.0e30f;
            sa[t9][j] = sv; mx = fmaxf(mx, sv);
        }
    return mx;
}
__device__ __forceinline__ void attn_phase(LAS unsigned char* lds, bf16_t* qkv, float* lse, const float* biasT, int G) {
    const int tid = ltid(), wave = __builtin_amdgcn_readfirstlane(tid >> 6), lane = tid & 63, half = wave >> 2, w4 = wave & 3, li = lane & 15, lg = lane >> 4, ht = tid & 255;
    LAS unsigned char* vs = lds + half * VS_BYTES;
    LAS float* bs = (LAS float*)(lds + 2 * VS_BYTES + half * 1024);
    const float scale2 = 0.08838834764831845f * 1.4426950408889634f;
    for (int i = ht; i < 16 * VS_PITCH / 16; i += 256) *(LAS u32x4*)(vs + 192 * VS_PITCH + i * 16) = (u32x4){0u, 0u, 0u, 0u};
    if (ht < 176) bs[ht] = 0.f;
    const int dl = 4 * lg - li, q4 = li >> 2, p4 = li & 3;
    const LAS float* bsl = bs + 16 + dl;
    const LAS unsigned char* vrd = vs + (16 * w4 + 4 * lg + q4) * VS_PITCH + (4 * p4) * 2;
    u32x4 vreg[12];
    const int nrounds = (4608 + G - 1) / G, cwg = blockIdx.x;
    { const int pair0 = attn_pair(0, cwg, G); if (pair0 < 4608) { const AttnItem a = attn_item(pair0 * 2 + half); attn_load_v(a, qkv, ht, vreg); } }
    __syncthreads();
    for (int j = 0; j < nrounds; ++j) {
        const int pair = attn_pair(j, cwg, G); if (pair >= 4608) break;
        const int pairn = (j + 1 < nrounds) ? attn_pair(j + 1, cwg, G) : 4608;
        const AttnItem a = attn_item(pair * 2 + half);
#pragma unroll
        for (int pass = 0; pass < 12; ++pass) *(LAS u32x4*)(vs + (pass * 16 + (ht >> 4)) * VS_PITCH + (ht & 15) * 16) = vreg[pass];
        if (ht < 129) bs[16 + ht] = biasT[a.head * 132 + ht];
        __syncthreads();
        const size_t tokq = (size_t)(a.pos0 + a.r + ((16 * w4 + li) << a.dsh));
        const int pbase = a.seq_base + a.r * a.m;
        bf16_t* qp = qkv + ((size_t)a.head * M_TOK + pbase + a.i0 + 16 * w4 + li) * 128;
        bf16x8 Qf[4];
#pragma unroll
        for (int ks = 0; ks < 4; ++ks) Qf[ks] = *(const bf16x8*)(qp + 32 * ks + 8 * lg);
        const int kbase = a.i0 - 64 + 16 * w4 + li;
        const bf16_t* kcol = qkv + ((size_t)(12 + a.head) * M_TOK + pbase) * 128 + 8 * lg;
        f32x4 sa[10];
        bf16x8 Kf[2][3][4];
#define ATT_LOADK(buf, grp) do { _Pragma("unroll") for (int tt = 0; tt < 3; ++tt) { int ki = kbase + 16 * ((grp) * 3 + tt); ki = ki < 0 ? 0 : (ki > a.m - 1 ? a.m - 1 : ki); \
            const bf16_t* kp = kcol + (size_t)ki * 128; \
            _Pragma("unroll") for (int ks = 0; ks < 4; ++ks) Kf[buf][tt][ks] = *(const bf16x8*)(kp + 32 * ks); } } while (0)
#define ATT_MMAK(buf, grp) do { _Pragma("unroll") for (int tt = 0; tt < 3; ++tt) { f32x4 acc_ = (f32x4){0.f, 0.f, 0.f, 0.f}; \
            _Pragma("unroll") for (int ks = 0; ks < 4; ++ks) acc_ = __builtin_amdgcn_mfma_f32_16x16x32_bf16(Kf[buf][tt][ks], Qf[ks], acc_, 0, 0, 0); sa[(grp) * 3 + tt] = acc_; } } while (0)
        ATT_LOADK(0, 0); ATT_LOADK(1, 1);
        __builtin_amdgcn_sched_barrier(0);
        ATT_MMAK(0, 0);
        __builtin_amdgcn_sched_barrier(0);
        ATT_LOADK(0, 2);
        if (pairn < 4608) { const AttnItem an = attn_item(pairn * 2 + half); attn_load_v(an, qkv, ht, vreg); }
        __builtin_amdgcn_sched_barrier(0);
        ATT_MMAK(1, 1);
        ATT_MMAK(0, 2);
#undef ATT_LOADK
#undef ATT_MMAK
        sa[9] = (f32x4){0.f, 0.f, 0.f, 0.f};
        const int kabs0 = a.i0 - 64 + 16 * w4 + 4 * lg;
        const bool edge = (a.i0 == 0) || (a.i0 + 64 == a.m);
        float mx = edge ? attn_scores<true>(sa, bsl, dl, kabs0, a.m, scale2) : attn_scores<false>(sa, bsl, dl, kabs0, a.m, scale2);
        mx = fmaxf(mx, __shfl_xor(mx, 16)); mx = fmaxf(mx, __shfl_xor(mx, 32));
        float sum = 0.f;
#pragma unroll
        for (int t9 = 0; t9 < 9; ++t9)
#pragma unroll
            for (int j = 0; j < 4; ++j) { const float pv = __builtin_amdgcn_exp2f(sa[t9][j] - mx); sa[t9][j] = pv; sum += pv; }
        sum += __shfl_xor(sum, 16); sum += __shfl_xor(sum, 32);
        bf16x8 Pf[5];
#pragma unroll
        for (int s5 = 0; s5 < 5; ++s5) {
            u32x4 w; w.x = cvt_pk_bf16(sa[2 * s5][0], sa[2 * s5][1]); w.y = cvt_pk_bf16(sa[2 * s5][2], sa[2 * s5][3]);
            w.z = cvt_pk_bf16(sa[2 * s5 + 1][0], sa[2 * s5 + 1][1]); w.w = cvt_pk_bf16(sa[2 * s5 + 1][2], sa[2 * s5 + 1][3]);
            Pf[s5] = __builtin_bit_cast(bf16x8, w);
        }
        const float inv = 1.0f / sum;
        f32x4 o[8];
#pragma unroll
        for (int dt = 0; dt < 8; ++dt) o[dt] = (f32x4){0.f, 0.f, 0.f, 0.f};
#pragma unroll
        for (int s5 = 0; s5 < 5; ++s5) {
            s16x4 va[8], vb[8];
#pragma unroll
            for (int dt = 0; dt < 8; ++dt) {
                va[dt] = __builtin_amdgcn_ds_read_tr16_b64_v4i16((LAS s16x4*)(vrd + (32 * s5) * VS_PITCH + 32 * dt));
                vb[dt] = __builtin_amdgcn_ds_read_tr16_b64_v4i16((LAS s16x4*)(vrd + (32 * s5 + 16) * VS_PITCH + 32 * dt));
            }
#pragma unroll
            for (int dt = 0; dt < 8; ++dt) {
                const bf16x8 Vf = (bf16x8){va[dt][0], va[dt][1], va[dt][2], va[dt][3], vb[dt][0], vb[dt][1], vb[dt][2], vb[dt][3]};
                o[dt] = __builtin_amdgcn_mfma_f32_16x16x32_bf16(Vf, Pf[s5], o[dt], 0, 0, 0);
            }
        }
#pragma unroll
        for (int dt = 0; dt < 8; ++dt) {
            const f32x4 ov = o[dt] * inv;
            u32x2 w; w.x = cvt_pk_bf16(ov[0], ov[1]); w.y = cvt_pk_bf16(ov[2], ov[3]);
            *(u32x2*)(qp + 16 * dt + 4 * lg) = w;
        }
        if (lg == 0) lse[tokq * 12 + a.head] = (mx + __log2f(sum)) * 0.6931471805599453f;
        __syncthreads();
    }
}

__device__ __forceinline__ void scan_merge_phase(const Params& p, int G) {
    const int tid = ltid(), lane = tid & 63;
    const bf16_t* S = (const bf16_t*)((unsigned char*)p.out + DO_XN);
    bf16_t* assm = (bf16_t*)(p.ws + WS_ASSM);
    for (int item = (tid >> 6) * G + blockIdx.x; item < 640; item += 8 * G) {
        const int g = item & 63, dir = (item >> 6) & 1, seq = item >> 7;
        const int n0 = seq < 4 ? seq * 512 : 2048, len = seq < 4 ? 512 : 1024;
        const float are = p.in[4][(dir * 64 + g) * 64 + lane], aim = p.in[5][(dir * 64 + g) * 64 + lane], dt = expf(p.in[6][dir * 64 + g]);
        const float mag = expf(16.0f * are * dt); float sn, cs; sincosf(16.0f * aim * dt, &sn, &cs);
        const float ar = mag * cs, ai = mag * sn;
        float hr = 0.f, hi = 0.f;
        const int nstart = dir == 0 ? n0 : n0 + len - 1; const long step = dir == 0 ? 1 : -1;
        const bf16_t* Sp = S + ((size_t)g * NCHUNK + nstart) * 256 + dir * 128 + lane;
        bf16_t* Ap = assm + ((size_t)g * NCHUNK + nstart) * 512 + 256 + dir * 128 + lane;
        const long sS = step * 256, sA = step * 512;
        float sr[2][16], si[2][16];
#define SCAN_LOAD(buf, b) do { _Pragma("unroll") for (int k = 0; k < 16; ++k) { sr[buf][k] = __uint_as_float((unsigned)Sp[((b) + k) * sS] << 16); si[buf][k] = __uint_as_float((unsigned)Sp[((b) + k) * sS + 64] << 16); } } while (0)
#define SCAN_STEP(buf, b) do { _Pragma("unroll") for (int k = 0; k < 16; ++k) { Ap[((b) + k) * sA] = f2bf(hr); Ap[((b) + k) * sA + 64] = f2bf(hi); \
            const float nr = ar * hr - ai * hi + sr[buf][k], ni = ar * hi + ai * hr + si[buf][k]; hr = nr; hi = ni; } } while (0)
        SCAN_LOAD(0, 0);
        for (int b = 0; b < len; b += 32) {
            SCAN_LOAD(1, b + 16);
            SCAN_STEP(0, b);
            if (b + 32 < len) SCAN_LOAD(0, b + 32);
            SCAN_STEP(1, b + 16);
        }
#undef SCAN_LOAD
#undef SCAN_STEP
    }
    const bf16_t* o = (const bf16_t*)(p.ws + WS_QKV); const float* lse = (const float*)(p.ws + WS_LSE);
    bf16_t* ya = (bf16_t*)((unsigned char*)p.out + DO_YATT);
    for (int idx0 = blockIdx.x * 512 + tid; idx0 < M_TOK * 64; idx0 += 2 * G * 512) {
        f32x4 a0[2], a1[2], b0[2], b1[2], c0[2], c1[2]; float w0[2], w1[2], w2[2];
#pragma unroll
        for (int q = 0; q < 2; ++q) {
            const int idx = idx0 + q * G * 512 < M_TOK * 64 ? idx0 + q * G * 512 : idx0;
            const int tok = idx >> 6, hh = (idx >> 4) & 3, ch = idx & 15;
            const float l0 = lse[tok * 12 + hh], l1 = lse[tok * 12 + 4 + hh], l2 = lse[tok * 12 + 8 + hh];
            int sbase, lsh; if (tok < 32768) { sbase = tok & ~8191; lsh = 13; } else { sbase = 32768; lsh = 14; }
            const int local = tok - sbase;
            const int p1 = sbase + ((local & 3) << (lsh - 2)) + (local >> 2), p2 = sbase + ((local & 15) << (lsh - 4)) + (local >> 4);
            unpack8(*(const u32x4*)(o + ((size_t)hh * M_TOK + tok) * 128 + ch * 8), a0[q], a1[q]);
            unpack8(*(const u32x4*)(o + ((size_t)(4 + hh) * M_TOK + p1) * 128 + ch * 8), b0[q], b1[q]);
            unpack8(*(const u32x4*)(o + ((size_t)(8 + hh) * M_TOK + p2) * 128 + ch * 8), c0[q], c1[q]);
            const float mx = fmaxf(l0, fmaxf(l1, l2)); w0[q] = __expf(l0 - mx); w1[q] = __expf(l1 - mx); w2[q] = __expf(l2 - mx);
            const float inv = 1.0f / (w0[q] + w1[q] + w2[q]); w0[q] *= inv; w1[q] *= inv; w2[q] *= inv;
        }
#pragma unroll
        for (int q = 0; q < 2; ++q) {
            const int idx = idx0 + q * G * 512; if (idx >= M_TOK * 64) continue;
            const int tok = idx >> 6, hh = (idx >> 4) & 3, ch = idx & 15;
            *(u32x4*)(ya + (size_t)tok * 512 + hh * 128 + ch * 8) = pack8(a0[q] * w0[q] + b0[q] * w1[q] + c0[q] * w2[q], a1[q] * w0[q] + b1[q] * w1[q] + c1[q] * w2[q]);
        }
    }
}

template <bool COOP>
__global__ void __launch_bounds__(512, 2) fwd_kernel(Params p) {
    extern __shared__ __attribute__((aligned(16))) unsigned char lds_raw[];
    LAS unsigned char* lds = (LAS unsigned char*)lds_raw;
    const int G = gridDim.x;
    XcdBarrier xb; xb.bar = (unsigned*)(p.ws + WS_BAR); xb.x = 0; xb.st = (volatile LAS unsigned*)(lds + 131072);
    bool posted = false;
    if constexpr (COOP) {
        if (threadIdx.x < 4) ((LAS unsigned*)(lds + 131072))[threadIdx.x] = 0u;
        if (blockIdx.x == 0) for (int i = threadIdx.x; i < XCD_BAR_WORDS; i += 512) __hip_atomic_store(xb.bar + i, 0u, __ATOMIC_RELAXED, __HIP_MEMORY_SCOPE_AGENT);
        __syncthreads();
    }
    for (int ph = p.ph_lo; ph < p.ph_hi; ++ph)
    for (int rep = 0; rep < (((PROBE_MASK >> ph) & 1u) ? 2 : 1); ++rep) {
        if ((ph > p.ph_lo || rep > 0) && !(COOP && ph == 7)) { if constexpr (COOP) {
            if (!posted) { cg::this_grid().sync(); xb = xcd_barrier_post((unsigned*)(p.ws + WS_BAR), (volatile LAS unsigned*)(lds + 131072)); posted = true; }
            else xcd_barrier(xb);
        } }
        unsigned char* ws = lptr(p.ws); unsigned char* dob = lptr((unsigned char*)p.out);
        const bf16_t* hb16 = (const bf16_t*)(ws + WS_GATES); const bf16_t* hfin16 = hb16 + (size_t)M_TOK * DM;
        if (ph == 0) { prep_phase(lds, p, G); continue; }
        if (ph == 3) { scan_merge_phase(p, G); continue; }
        if (ph == 9) { rms_rows_b16<true>(hb16, p.in[17], (void*)(dob + DO_XN), G); continue; }
        if (ph == N_PHASES - 1) { rms_rows_b16<false>(hfin16, p.in[21], (void*)p.out, G); continue; }
        bf16_t* assm = (bf16_t*)(ws + WS_ASSM); bf16_t* z = (bf16_t*)(dob + DO_XN);
        pg8::GemmD g; pg8::Sched S; pg8::Epi E;
        E.ws = ws; E.dob = dob; E.bglu = p.in[13]; E.x0 = p.in[0]; E.x1 = p.in[1]; E.hoff = 0;
        S.G = G; S.c = blockIdx.x; S.ssm = 0; S.nM = M_TOK / 256;
        if (ph == 1) { g = {z, (const bf16_t*)(dob + DO_WIN), DM, DM, DM}; S.nN = 38; E.mode = pg8::EM_INPROJ; }
        else if (ph == 2) { g = {assm, (const bf16_t*)(dob + DO_BTS), 512, 256, 256}; S.ssm = 1; S.nM = 768; S.nN = 1; E.mode = pg8::EM_SSM_S; }
        else if (ph == 4) { g = {assm, (const bf16_t*)(dob + DO_BTY), 512, 512, 512}; S.ssm = 1; S.nM = 768; S.nN = 1; E.mode = pg8::EM_SSM_Y; }
        else if (ph == 5) { g = {z, (const bf16_t*)(dob + DO_WGLU), SSMW, SSMW, SSMW}; S.nN = 4; E.mode = pg8::EM_GLU; }
        else if (ph == 6) { g = {z + (size_t)M_TOK * SSMW, (const bf16_t*)(dob + DO_WBS), SSMW, SSMW, SSMW}; S.nN = 8; E.mode = pg8::EM_BR1; }
        else if (ph == 7) { g = {(const bf16_t*)(dob + DO_YATT), (const bf16_t*)(dob + DO_WBA), 512, 512, 512}; S.nN = 8; E.mode = pg8::EM_BR2; }
        else if (ph == 8) { g = {(const bf16_t*)(ws + WS_QKV), (const bf16_t*)(dob + DO_WOUT), DM, DM, DM}; S.nN = 8; E.mode = pg8::EM_OUT; }
        else {
            const int c = (ph - 10) >> 1;
            if (((ph - 10) & 1) == 0) { g = {z + (size_t)c * FF_ROWS * DM, (const bf16_t*)(dob + DO_WFF1), DM, DM, DM}; S.nM = FF_ROWS / 256; S.nN = 32; E.mode = pg8::EM_FF1; }
            else { g = {(const bf16_t*)(ws + WS_QKV), (const bf16_t*)(dob + DO_WFF2), DFF, DFF, DFF}; S.nM = FF_ROWS / 256; S.nN = 8; E.mode = pg8::EM_FF2; E.hoff = (size_t)c * FF_ROWS * DM; }
        }
        S.nwg = S.nM * S.nN;
        pg8::gemm_phase(lds, g, S, E);
        if (ph == 2) attn_phase(lds, (bf16_t*)(ws + WS_QKV), (float*)(ws + WS_LSE), (const float*)(ws + WS_BIAS), G);
    }
}

extern "C" void kernel_launch(void* const* d_in, const int* in_sizes, int n_in, void* d_out, int out_size, void* d_ws, size_t ws_size, hipStream_t stream) {
    static int grid = 0;
    if (grid == 0) {
        if (n_in != 22 || out_size != M_TOK * DM || ws_size < WS_END) { fprintf(stderr, "kernel_launch: unexpected shapes (n_in %d, out %d, ws %zu, need %zu)\n", n_in, out_size, ws_size, (size_t)WS_END); grid = -1; return; }
        int dev = 0, cus = 0, per_cu = 0;
        (void)hipGetDevice(&dev); (void)hipDeviceGetAttribute(&cus, hipDeviceAttributeMultiprocessorCount, dev);
        (void)hipFuncSetAttribute((const void*)fwd_kernel<true>, hipFuncAttributeMaxDynamicSharedMemorySize, LDS_BYTES);
        (void)hipFuncSetAttribute((const void*)fwd_kernel<false>, hipFuncAttributeMaxDynamicSharedMemorySize, LDS_BYTES);
        (void)hipOccupancyMaxActiveBlocksPerMultiprocessor(&per_cu, (const void*)fwd_kernel<true>, 512, LDS_BYTES);
        if (per_cu < 1) per_cu = 1;
        (void)hipGetLastError();
        grid = cus * per_cu; if (grid > 256) grid = 256; if (grid < 1) grid = 256;
    }
    if (grid < 0) return;
    Params p{};
    for (int i = 0; i < 22; ++i) p.in[i] = (const float*)d_in[i];
    p.out = (float*)d_out; p.ws = (unsigned char*)d_ws;
#if MK_COOP
    p.ph_lo = 0; p.ph_hi = N_PHASES;
    void* args[] = {&p};
    hipError_t e = hipLaunchCooperativeKernel((const void*)fwd_kernel<true>, dim3(grid), dim3(512), args, LDS_BYTES, stream);
    if (e != hipSuccess) fprintf(stderr, "cooperative launch failed: %s (grid %d)\n", hipGetErrorString(e), grid);
#else
    for (int ph = 0; ph < N_PHASES; ++ph) {
        p.ph_lo = ph; p.ph_hi = ph + 1;
        hipLaunchKernelGGL(fwd_kernel<false>, dim3(grid), dim3(512), LDS_BYTES, stream, p);
    }
#endif
}
```

```cpp
#include <hip/hip_runtime.h>
#include <hip/hip_cooperative_groups.h>
#include <cstdio>
#include <cstdint>
namespace cg = cooperative_groups;

#ifndef MK_COOP
#define MK_COOP 1
#endif

#ifndef PROBE_MASK
#define PROBE_MASK 0u
#endif
#define LAS __attribute__((address_space(3)))
typedef unsigned short bf16_t;
typedef short bf16x8 __attribute__((ext_vector_type(8)));
typedef short s16x4 __attribute__((ext_vector_type(4)));
typedef float f32x4 __attribute__((ext_vector_type(4)));
typedef unsigned u32x4 __attribute__((ext_vector_type(4)));
typedef unsigned u32x2 __attribute__((ext_vector_type(2)));

constexpr int M_TOK = 49152, DM = 2048, SSMW = 1024, QKVW = 4608, GATEW = 4096, DFF = 8192;
constexpr int NCHUNK = M_TOK / 16;
constexpr int FF_ROWS = 24576, N_FFC = 2;
constexpr int N_PHASES = 9 + 2 * N_FFC + 1;
constexpr int LDS_BYTES = 131072 + 16;

constexpr size_t WS_ASSM = 0;
constexpr size_t WS_QKV = 201326592;
constexpr size_t WS_GATES = WS_QKV + 452984832;
constexpr size_t WS_LSE = WS_GATES + 402653184;
constexpr size_t WS_BIAS = WS_LSE + 2359296;
constexpr size_t WS_BAR = WS_BIAS + 8192;
constexpr size_t WS_RS2 = WS_BAR + 16384;
constexpr size_t WS_END = WS_RS2 + 196608;
constexpr size_t DO_WIN = 0, DO_WGLU = 39845888, DO_WBS = 41943040, DO_WBA = 46137344, DO_WOUT = 48234496, DO_WFF1 = 56623104, DO_WFF2 = 90177536;
constexpr size_t DO_BTY = 123731968;
constexpr size_t DO_BTS = 140509184;
constexpr size_t DO_XN = 148897792;
constexpr size_t DO_YATT = 350224384;

typedef __bf16 bf16x2_t __attribute__((ext_vector_type(2)));
typedef float f32x2_t __attribute__((ext_vector_type(2)));
__device__ __forceinline__ unsigned cvt_pk_bf16(float lo, float hi) { const bf16x2_t r = __builtin_convertvector((f32x2_t){lo, hi}, bf16x2_t); return __builtin_bit_cast(unsigned, r); }
__device__ __forceinline__ bf16_t f2bf(float f) { unsigned u = __float_as_uint(f); u += 0x7FFFu + ((u >> 16) & 1u); return (bf16_t)(u >> 16); }
__device__ __forceinline__ float bflo(unsigned w) { return __uint_as_float(w << 16); }
__device__ __forceinline__ float bfhi(unsigned w) { return __uint_as_float(w & 0xffff0000u); }
__device__ __forceinline__ void unpack8(const u32x4 w, f32x4& a, f32x4& b) { a = (f32x4){bflo(w.x), bfhi(w.x), bflo(w.y), bfhi(w.y)}; b = (f32x4){bflo(w.z), bfhi(w.z), bflo(w.w), bfhi(w.w)}; }
__device__ __forceinline__ u32x4 pack8(const f32x4 a, const f32x4 b) { u32x4 w; w.x = cvt_pk_bf16(a[0], a[1]); w.y = cvt_pk_bf16(a[2], a[3]); w.z = cvt_pk_bf16(b[0], b[1]); w.w = cvt_pk_bf16(b[2], b[3]); return w; }
__device__ __forceinline__ float sigmoidf_(float x) { return __builtin_amdgcn_rcpf(1.0f + __builtin_amdgcn_exp2f(-1.4426950408889634f * x)); }
__device__ __forceinline__ float gelu_tanh(float x) { const float y = 0.7978845608028654f * (x + 0.044715f * x * x * x); return x * __builtin_amdgcn_rcpf(1.0f + __builtin_amdgcn_exp2f(-2.8853900817779268f * y)); }

__device__ __forceinline__ int ltid() { int t = threadIdx.x; asm volatile("" : "+v"(t)); return t; }
__device__ __forceinline__ size_t opaque_zero() { size_t z = 0; asm volatile("" : "+s"(z)); return z; }
template <class T> __device__ __forceinline__ T* lptr(T* p) { return (T*)((unsigned char*)p + opaque_zero()); }
namespace pg8 {
constexpr int BM = 256, BK = 64, HALF = 128, HTB = HALF * BK * 2, NXCD = 8, WGM = 4;
__device__ __forceinline__ int lds_byte(int r, int c) { const int st = (r >> 4) * 2 + (c >> 5), rr = r & 15, cc = c & 31, ob = rr * 64 + cc * 2; return st * 1024 + (ob ^ (((ob >> 9) & 1) << 5)); }
__device__ __forceinline__ void stage_rc(int b, int& R, int& C) { const int st = b / 1024, sb = b % 1024, swz = sb ^ (((sb >> 9) & 1) << 5); R = (st >> 1) * 16 + swz / 64; C = (st & 1) * 32 + (swz % 64) / 2; }
__device__ __forceinline__ int perm32(int rho) { const int n = rho >> 4, i = rho & 15; return 8 * (i >> 2) + 4 * n + (i & 3); }

struct Unit { int pm, pn; };
struct GemmD { const bf16_t* A; const bf16_t* Bt; int lda, ldb, K; };

struct Sched {
    int nM, nN, nwg, G, c, ssm;
    __device__ __forceinline__ bool next(int i, Unit& u) const {
        const long L = (long)i * G + c; if (L >= nwg) return false;
        if (ssm) { u.pm = (int)L; u.pn = (int)L / 12; return true; }
        int wgid = (int)L; { const int q = nwg / NXCD, r = nwg % NXCD, xcd = wgid % NXCD, off = wgid / NXCD; wgid = (xcd < r ? xcd * (q + 1) : r * (q + 1) + (xcd - r) * q) + off; }
        const int nig = WGM * nN, gid = wgid / nig, fm = gid * WGM, gsz = (nM - fm) < WGM ? (nM - fm) : WGM;
        u.pm = fm + ((wgid % nig) % gsz); u.pn = (wgid % nig) / gsz; return true;
    }
};

enum { EM_INPROJ = 0, EM_SSM_S, EM_SSM_Y, EM_GLU, EM_BR1, EM_BR2, EM_OUT, EM_FF1, EM_FF2 };
struct Epi {
    int mode; unsigned char* ws; unsigned char* dob; const float* bglu; const float* x0; const float* x1; size_t hoff; int roff;
};
struct EpiP { bf16_t* assm; bf16_t* qkv; bf16_t* gates; bf16_t* S; bf16_t* z; const float* bglu; bf16_t* yssm; bf16_t* mixed; const float* x0; const float* x1; bf16_t* hb; bf16_t* hfin; bf16_t* act; const float* rs2; };

template <int MODE>
__device__ __forceinline__ void epi_body(const Epi& E0, const f32x4 (&acc)[2][2][4][2], const Unit& u, int wr, int wc, int fr, int fq) {
    asm volatile("" : "+v"(fr), "+v"(fq));
    unsigned char* ws = lptr(E0.ws); unsigned char* dob = lptr(E0.dob);
    EpiP E;
    E.assm = (bf16_t*)(ws + WS_ASSM); E.qkv = (bf16_t*)(ws + WS_QKV); E.gates = (bf16_t*)(ws + WS_GATES); E.S = (bf16_t*)(dob + DO_XN); E.z = (bf16_t*)(dob + DO_XN);
    E.bglu = E0.bglu; E.yssm = E.z + (size_t)M_TOK * SSMW; E.mixed = (bf16_t*)(ws + WS_QKV); E.x0 = E0.x0; E.x1 = E0.x1; E.hb = (bf16_t*)(ws + WS_GATES) + E0.hoff; E.hfin = (bf16_t*)(ws + WS_GATES) + (size_t)M_TOK * DM + E0.hoff; E.act = (bf16_t*)(ws + WS_QKV); E.rs2 = (const float*)(ws + WS_RS2);
    const int row0 = u.pm * BM + wr * 64 + fr, cl0 = wc * 32 + 8 * fq;
#pragma unroll
    for (int ai = 0; ai < 2; ++ai)
#pragma unroll
        for (int m = 0; m < 4; ++m) {
            const int r = row0 + ai * HALF + m * 16;
            float rs2 = 1.0f;
            if constexpr (MODE == EM_FF2) rs2 = E.rs2[E0.roff + r];
#pragma unroll
            for (int bj = 0; bj < 2; ++bj) {
                const int cl = cl0 + bj * HALF;
                f32x4 v0 = acc[ai][bj][m][0], v1 = acc[ai][bj][m][1];
                if constexpr (MODE == EM_INPROJ) {
                    if (u.pn < 4) {
                        const int col = u.pn * 256 + cl, g = col >> 4, cc = col & 15, chunk = r >> 4, t = r & 15;
                        *(u32x4*)(E.assm + ((size_t)(g * NCHUNK + chunk) * 512 + t * 16 + cc)) = pack8(v0, v1);
                    } else if (u.pn < 22) {
                        const int hidx = (u.pn - 4) * 2 + bj, tensor = hidx / 12, head = hidx - tensor * 12, dcol = cl & 127, dsh = (head >> 2) * 2;
                        int sbase, lsh; if (r < 32768) { sbase = r & ~8191; lsh = 13; } else { sbase = 32768; lsh = 14; }
                        const int local = r - sbase, perm = sbase + ((local & ((1 << dsh) - 1)) << (lsh - dsh)) + (local >> dsh);
                        *(u32x4*)(E.qkv + ((size_t)hidx * M_TOK + perm) * 128 + dcol) = pack8(v0, v1);
                    } else {
#pragma unroll
                        for (int j = 0; j < 4; ++j) { v0[j] = sigmoidf_(v0[j]); v1[j] = sigmoidf_(v1[j]); }
                        *(u32x4*)(E.gates + (size_t)r * GATEW + (u.pn - 22) * 256 + cl) = pack8(v0, v1);
                    }
                } else if constexpr (MODE == EM_SSM_S) {
                    *(u32x4*)(E.S + (size_t)r * 256 + cl) = pack8(v0, v1);
                } else if constexpr (MODE == EM_SSM_Y) {
                    const int g = u.pm / 12, chunk = r - g * NCHUNK, t = cl >> 4, cc = cl & 15, tok = chunk * 16 + t;
#pragma unroll
                    for (int j = 0; j < 4; ++j) { v0[j] = gelu_tanh(v0[j]); v1[j] = gelu_tanh(v1[j]); }
                    *(u32x4*)(E.z + (size_t)tok * SSMW + g * 16 + cc) = pack8(v0, v1);
                } else if constexpr (MODE == EM_GLU) {
                    const int c = u.pn * 256 + cl; const size_t off = (size_t)r * SSMW + c;
                    f32x4 z0, z1; unpack8(*(const u32x4*)(E.z + off), z0, z1);
                    const f32x4 b0 = *(const f32x4*)(E.bglu + c), b1 = *(const f32x4*)(E.bglu + c + 4);
#pragma unroll
                    for (int j = 0; j < 4; ++j) { v0[j] = z0[j] * sigmoidf_(v0[j] + b0[j]); v1[j] = z1[j] * sigmoidf_(v1[j] + b1[j]); }
                    *(u32x4*)(E.yssm + off) = pack8(v0, v1);
                } else if constexpr (MODE == EM_BR1) {
                    const int c = u.pn * 256 + cl;
                    f32x4 g0, g1; unpack8(*(const u32x4*)(E.gates + (size_t)r * GATEW + c), g0, g1);
                    *(u32x4*)(E.mixed + (size_t)r * DM + c) = pack8(g0 * v0, g1 * v1);
                } else if constexpr (MODE == EM_BR2) {
                    const int c = u.pn * 256 + cl;
                    f32x4 g0, g1, m0, m1; unpack8(*(const u32x4*)(E.gates + (size_t)r * GATEW + DM + c), g0, g1);
                    bf16_t* mp = E.mixed + (size_t)r * DM + c; unpack8(*(const u32x4*)mp, m0, m1);
                    *(u32x4*)mp = pack8(m0 + g0 * v0, m1 + g1 * v1);
                } else if constexpr (MODE == EM_OUT) {
                    const int c = u.pn * 256 + cl;
                    const float* xr = (r < 32768 ? E.x0 + (size_t)r * DM : E.x1 + (size_t)(r - 32768) * DM) + c;
                    *(u32x4*)(E.hb + (size_t)r * DM + c) = pack8(*(const f32x4*)xr + v0, *(const f32x4*)(xr + 4) + v1);
                } else if constexpr (MODE == EM_FF1) {
                    const int c = u.pn * 256 + cl;
#pragma unroll
                    for (int j = 0; j < 4; ++j) { const float a = fmaxf(v0[j], 0.f), b = fmaxf(v1[j], 0.f); v0[j] = a * a; v1[j] = b * b; }
                    *(u32x4*)(E.act + (size_t)r * DFF + c) = pack8(v0, v1);
                } else if constexpr (MODE == EM_FF2) {
                    const int c = u.pn * 256 + cl;
                    f32x4 h0, h1; unpack8(*(const u32x4*)(E.hb + (size_t)r * DM + c), h0, h1);
                    *(u32x4*)(E.hfin + (size_t)r * DM + c) = pack8(h0 + v0 * rs2, h1 + v1 * rs2);
                }
            }
        }
}
__device__ __forceinline__ void epi_run(const Epi& E, const f32x4 (&acc)[2][2][4][2], const Unit& u, int wr, int wc, int fr, int fq) {
    switch (E.mode) {
        case EM_INPROJ: epi_body<EM_INPROJ>(E, acc, u, wr, wc, fr, fq); break;
        case EM_SSM_S: epi_body<EM_SSM_S>(E, acc, u, wr, wc, fr, fq); break;
        case EM_SSM_Y: epi_body<EM_SSM_Y>(E, acc, u, wr, wc, fr, fq); break;
        case EM_GLU: epi_body<EM_GLU>(E, acc, u, wr, wc, fr, fq); break;
        case EM_BR1: epi_body<EM_BR1>(E, acc, u, wr, wc, fr, fq); break;
        case EM_BR2: epi_body<EM_BR2>(E, acc, u, wr, wc, fr, fq); break;
        case EM_OUT: epi_body<EM_OUT>(E, acc, u, wr, wc, fr, fq); break;
        case EM_FF1: epi_body<EM_FF1>(E, acc, u, wr, wc, fr, fq); break;
        default: epi_body<EM_FF2>(E, acc, u, wr, wc, fr, fq); break;
    }
}

__device__ __forceinline__ void gemm_phase(LAS unsigned char* lds, const GemmD g, const Sched& S, const Epi& E) {
    const int tid = ltid(), wid = __builtin_amdgcn_readfirstlane(tid >> 6), lane = tid & 63, wr = wid >> 2, wc = wid & 3, fr = lane & 15, fq = lane >> 4;
    const int K = g.K, nt = K / BK;
    unsigned voffA[2], voffB[2];
#pragma unroll
    for (int i = 0; i < 2; ++i) { int R, C; stage_rc(tid * 16 + i * 8192, R, C); const int Rb = (R & ~31) + perm32(R & 31);
        voffA[i] = (unsigned)(R * g.lda + C) * 2u; voffB[i] = (unsigned)(Rb * g.ldb + C) * 2u; }
    const size_t kstep = (size_t)(BK * 2);
    const size_t hstepA = (size_t)HALF * g.lda * 2, tstepA = 2 * hstepA;
    const size_t hstepB = (size_t)HALF * g.ldb * 2, tstepB = 2 * hstepB;
    const unsigned ldsw = (unsigned)wid * 1024u;
    const int aoff = lds_byte(wr * 64 + fr, fq * 8), boff = lds_byte(wc * 32 + fr, fq * 8);
#define PG8_SA(b, h) (((b) * 2 + (h)) * HTB)
#define PG8_SB(b, h) ((4 + (b) * 2 + (h)) * HTB)
#define PG8_STAGE(bufoff, gbase, voff) do { _Pragma("unroll") for (int _i = 0; _i < 2; ++_i) \
        __builtin_amdgcn_global_load_lds((const unsigned*)((const char*)(gbase) + (voff)[_i]), (LAS unsigned*)(lds + (bufoff) + ldsw + _i * 8192), 16, 0, 0); } while (0)
#define PG8_LDA(dst, b, h) do { _Pragma("unroll") for (int m = 0; m < 4; ++m) _Pragma("unroll") for (int k = 0; k < 2; ++k) dst[m][k] = *(const LAS bf16x8*)(lds + PG8_SA(b, h) + aoff + m * 2048 + k * 1024); } while (0)
#define PG8_LDB(dst, b, h) do { _Pragma("unroll") for (int n = 0; n < 2; ++n) _Pragma("unroll") for (int k = 0; k < 2; ++k) dst[n][k] = *(const LAS bf16x8*)(lds + PG8_SB(b, h) + boff + n * 2048 + k * 1024); } while (0)
#define PG8_MMA(ai, bj, At, Bt) do { __builtin_amdgcn_s_setprio(1); _Pragma("unroll") for (int m = 0; m < 4; ++m) _Pragma("unroll") for (int n = 0; n < 2; ++n) _Pragma("unroll") for (int k = 0; k < 2; ++k) \
        acc[ai][bj][m][n] = __builtin_amdgcn_mfma_f32_16x16x32_bf16(Bt[n][k], At[m][k], acc[ai][bj][m][n], 0, 0, 0); __builtin_amdgcn_s_setprio(0); } while (0)
#define PG8_WAIT_V(n) asm volatile("s_waitcnt vmcnt(" #n ")" ::: "memory")
#define PG8_WAIT_L(n) asm volatile("s_waitcnt lgkmcnt(" #n ")" ::: "memory")
#define PG8_BAR __builtin_amdgcn_s_barrier()
#define PG8_SCHED __builtin_amdgcn_sched_barrier(0)
    Unit cur, nxt; int ui = 0;
    if (!S.next(0, cur)) return;
    f32x4 acc[2][2][4][2];
#pragma unroll
    for (int a = 0; a < 2; ++a)
#pragma unroll
        for (int b = 0; b < 2; ++b)
#pragma unroll
            for (int m = 0; m < 4; ++m)
#pragma unroll
                for (int n = 0; n < 2; ++n) acc[a][b][m][n] = (f32x4){0.f, 0.f, 0.f, 0.f};
    bf16x8 At[4][2], B0[2][2], B1[2][2];
    const char* cA = (const char*)g.A + (size_t)cur.pm * tstepA; const char* cB = (const char*)g.Bt + (size_t)cur.pn * tstepB;
    PG8_STAGE(PG8_SB(0, 0), cB, voffB); PG8_STAGE(PG8_SB(0, 1), cB + hstepB, voffB); PG8_STAGE(PG8_SA(0, 0), cA, voffA); PG8_STAGE(PG8_SA(0, 1), cA + hstepA, voffA);
    if (wr == 1) PG8_BAR;
    PG8_WAIT_V(2); PG8_BAR;
    PG8_STAGE(PG8_SB(1, 0), cB + kstep, voffB); PG8_STAGE(PG8_SA(1, 0), cA + kstep, voffA); PG8_STAGE(PG8_SB(1, 1), cB + hstepB + kstep, voffB);
    PG8_WAIT_V(6); PG8_BAR;
    for (;;) {
        const bool has_next = S.next(ui + 1, nxt);
        const char* nA = has_next ? (const char*)g.A + (size_t)nxt.pm * tstepA : cA; const char* nB = has_next ? (const char*)g.Bt + (size_t)nxt.pn * tstepB : cB;
        for (int t = 0; t < nt; t += 2) {
            const bool last = (t == nt - 2);
            const char* a1 = cA + (size_t)(t + 1) * kstep;
            const char* a2 = last ? nA : cA + (size_t)(t + 2) * kstep; const char* b2 = last ? nB : cB + (size_t)(t + 2) * kstep;
            const char* a3 = a2 + kstep; const char* b3 = b2 + kstep;
            PG8_LDB(B0, 0, 0); PG8_LDB(B1, 0, 1); PG8_SCHED; PG8_LDA(At, 0, 0); PG8_STAGE(PG8_SA(1, 1), a1 + hstepA, voffA);
            PG8_WAIT_V(8); PG8_WAIT_L(0); PG8_BAR; PG8_MMA(0, 0, At, B0); PG8_MMA(0, 1, At, B1); PG8_BAR; PG8_SCHED;
            PG8_LDA(At, 0, 1); PG8_STAGE(PG8_SB(0, 0), b2, voffB); PG8_STAGE(PG8_SB(0, 1), b2 + hstepB, voffB); PG8_STAGE(PG8_SA(0, 0), a2, voffA);
            PG8_WAIT_V(8); PG8_WAIT_L(0); PG8_BAR; PG8_MMA(1, 0, At, B0); PG8_MMA(1, 1, At, B1); PG8_BAR; PG8_SCHED;
            PG8_LDB(B0, 1, 0); PG8_LDB(B1, 1, 1); PG8_SCHED; PG8_LDA(At, 1, 0); PG8_STAGE(PG8_SA(0, 1), a2 + hstepA, voffA);
            PG8_WAIT_V(8); PG8_WAIT_L(0); PG8_BAR; PG8_MMA(0, 0, At, B0); PG8_MMA(0, 1, At, B1); PG8_BAR; PG8_SCHED;
            PG8_LDA(At, 1, 1); PG8_STAGE(PG8_SB(1, 0), b3, voffB); PG8_STAGE(PG8_SB(1, 1), b3 + hstepB, voffB); PG8_STAGE(PG8_SA(1, 0), a3, voffA);
            PG8_WAIT_V(8); PG8_WAIT_L(0); PG8_BAR; PG8_MMA(1, 0, At, B0); PG8_MMA(1, 1, At, B1); PG8_BAR; PG8_SCHED;
        }
        if (wr == 0) PG8_BAR;
        epi_run(E, acc, cur, wr, wc, fr, fq);
        if (!has_next) break;
#pragma unroll
        for (int a = 0; a < 2; ++a)
#pragma unroll
            for (int b = 0; b < 2; ++b)
#pragma unroll
                for (int m = 0; m < 4; ++m)
#pragma unroll
                    for (int n = 0; n < 2; ++n) acc[a][b][m][n] = (f32x4){0.f, 0.f, 0.f, 0.f};
        cur = nxt; cA = nA; cB = nB; ++ui;
        if (wr == 1) PG8_BAR;
    }
    PG8_WAIT_V(0);
    PG8_BAR;
#undef PG8_SA
#undef PG8_SB
#undef PG8_STAGE
#undef PG8_LDA
#undef PG8_LDB
#undef PG8_MMA
#undef PG8_WAIT_V
#undef PG8_WAIT_L
#undef PG8_BAR
#undef PG8_SCHED
}
}

#define XB_TMO      128
#define XB_XCNT(j)  (256  + 64 * (j))
#define XB_XSUB(j)  (1280 + 64 * (j))
#define XB_XGEN(j)  (2304 + 64 * (j))
#define XB_TOP      3328
#define XB_TOPGEN   3392
#define XCD_BAR_WORDS 3456
#define XB_SPIN_CAP (1u << 22)
__device__ __forceinline__ unsigned xb_ld(unsigned* p)              { return __hip_atomic_load(p, __ATOMIC_RELAXED, __HIP_MEMORY_SCOPE_AGENT); }
__device__ __forceinline__ unsigned xb_add(unsigned* p, unsigned v) { return __hip_atomic_fetch_add(p, v, __ATOMIC_RELAXED, __HIP_MEMORY_SCOPE_AGENT); }
__device__ __forceinline__ unsigned xb_xcc_id() { return (unsigned)__builtin_amdgcn_s_getreg((3 << 11) | 20) & 0xFu; }
#define XB_SPIN(cond, bar) do { unsigned _sp = 0; while (cond) { __builtin_amdgcn_s_sleep(1); \
    if ((++_sp & 255u) == 0u) { if (xb_ld(&(bar)[XB_TMO])) break; if (_sp > XB_SPIN_CAP) { atomicAdd(&(bar)[XB_TMO], 1u); break; } } } } while (0)
struct XcdBarrier { unsigned* bar; unsigned x; volatile LAS unsigned* st; };
__device__ __forceinline__ XcdBarrier xcd_barrier_post(unsigned* bar, volatile LAS unsigned* st) {
    XcdBarrier b; b.bar = bar; b.x = xb_xcc_id(); b.st = st;
    if (threadIdx.x == 0) (void)xb_add(&bar[XB_XCNT(b.x)], 1u);
    return b;
}
__device__ __forceinline__ void xcd_barrier_complete(unsigned* bar, unsigned x, unsigned& nloc, unsigned& nx) {
    const unsigned G = gridDim.x * gridDim.y * gridDim.z;
    unsigned sum, cnt, mine, sp = 0u;
    for (;;) {
        sum = 0u; cnt = 0u; mine = 0u;
#pragma unroll
        for (unsigned j = 0; j < 16; ++j) { const unsigned c = xb_ld(&bar[XB_XCNT(j)]); sum += c; cnt += (c > 0u) ? 1u : 0u; mine = (j == x) ? c : mine; }
        if (sum == G) break;
        __builtin_amdgcn_s_sleep(1);
        if ((++sp & 255u) == 0u) { if (xb_ld(&bar[XB_TMO])) break; if (sp > XB_SPIN_CAP) { atomicAdd(&bar[XB_TMO], 1u); break; } }
    }
    nloc = mine > 0u ? mine : 1u; nx = cnt > 0u ? cnt : 1u;
}
__device__ __forceinline__ void xcd_barrier(const XcdBarrier& b) {
    asm volatile("s_waitcnt vmcnt(0)" ::: "memory");
    __syncthreads();
    if (threadIdx.x == 0) {
        unsigned* bar = b.bar;
        __builtin_amdgcn_s_waitcnt(0);
        unsigned nloc = b.st[0], nx = b.st[1];
        if (nloc == 0u) { xcd_barrier_complete(bar, b.x, nloc, nx); b.st[0] = nloc; b.st[1] = nx; }
        const unsigned old = xb_add(&bar[XB_XSUB(b.x)], 1u);
        const unsigned gen = old / nloc;
        if (old + 1u == (gen + 1u) * nloc) {
            __builtin_amdgcn_fence(__ATOMIC_RELEASE, "agent");
            asm volatile("s_waitcnt vmcnt(0)" ::: "memory");
            const unsigned og = xb_add(&bar[XB_TOP], 1u);
            const unsigned tg = og / nx;
            if (og + 1u == (tg + 1u) * nx) xb_add(&bar[XB_TOPGEN], 1u);
            else XB_SPIN(xb_ld(&bar[XB_TOPGEN]) == tg, bar);
            __builtin_amdgcn_fence(__ATOMIC_ACQUIRE, "agent");
            xb_add(&bar[XB_XGEN(b.x)], 1u);
            asm volatile("s_waitcnt vmcnt(0)" ::: "memory");
        } else {
            XB_SPIN(xb_ld(&bar[XB_XGEN(b.x)]) == gen, bar);
            __builtin_amdgcn_fence(__ATOMIC_ACQUIRE, "agent");
            asm volatile("s_waitcnt vmcnt(0)" ::: "memory");
        }
    }
    __syncthreads();
}

struct Params { const float* in[22]; float* out; unsigned char* ws; int ph_lo, ph_hi; };

__device__ __forceinline__ void ssm_prep(LAS unsigned char* lds, const Params& p, int g) {
    const float* a_re = p.in[4]; const float* a_im = p.in[5]; const float* log_dt = p.in[6];
    const float* b_re = p.in[7]; const float* b_im = p.in[8]; const float* c_re = p.in[9]; const float* c_im = p.in[10]; const float* dskip = p.in[11];
    LAS float* apow = (LAS float*)lds;
    LAS float* Bb = apow + 2 * 17 * 64 * 2;
    LAS float* Cc = Bb + 2 * 64 * 16 * 2;
    LAS float* Kt = Cc + 2 * 16 * 64 * 2;
    const int tid = ltid();
    for (int idx = tid; idx < 2 * 17 * 64; idx += 512) {
        const int dir = idx / (17 * 64), j = (idx / 64) % 17, pp = idx % 64;
        const float are = a_re[(dir * 64 + g) * 64 + pp], aim = a_im[(dir * 64 + g) * 64 + pp], dt = expf(log_dt[dir * 64 + g]);
        const float x = are * dt * (float)j, y = aim * dt * (float)j; const float mag = expf(x); float s, c; sincosf(y, &s, &c);
        apow[idx * 2] = mag * c; apow[idx * 2 + 1] = mag * s;
    }
    for (int idx = tid; idx < 2 * 64 * 16; idx += 512) {
        const int dir = idx / 1024, pp = (idx / 16) % 64, c = idx % 16;
        const float are = a_re[(dir * 64 + g) * 64 + pp], aim = a_im[(dir * 64 + g) * 64 + pp], dt = expf(log_dt[dir * 64 + g]);
        const float x = are * dt, y = aim * dt; const float ex1 = expm1f(x); float sy, cy; sincosf(y, &sy, &cy); const float sh = sinf(0.5f * y);
        const float nr = ex1 * cy - 2.0f * sh * sh, ni = (ex1 + 1.0f) * sy;
        const float den = are * are + aim * aim; const float qr = (nr * are + ni * aim) / den, qi = (ni * are - nr * aim) / den;
        const float br = b_re[((dir * 64 + g) * 64 + pp) * 16 + c], bi = b_im[((dir * 64 + g) * 64 + pp) * 16 + c];
        Bb[idx * 2] = qr * br - qi * bi; Bb[idx * 2 + 1] = qr * bi + qi * br;
    }
    for (int idx = tid; idx < 2 * 16 * 64; idx += 512) {
        const int dir = idx / 1024, c = (idx / 64) % 16, pp = idx % 64;
        Cc[idx * 2] = c_re[((dir * 64 + g) * 16 + c) * 64 + pp]; Cc[idx * 2 + 1] = c_im[((dir * 64 + g) * 16 + c) * 64 + pp];
    }
    __syncthreads();
    for (int idx = tid; idx < 8192; idx += 512) {
        const int dir = idx >> 12, j = (idx >> 8) & 15, c = (idx >> 4) & 15, c2 = idx & 15;
        float acc = 0.f;
        for (int pp = 0; pp < 64; ++pp) {
            const float ar = apow[((dir * 17 + j) * 64 + pp) * 2], ai = apow[((dir * 17 + j) * 64 + pp) * 2 + 1];
            const float cr = Cc[((dir * 16 + c) * 64 + pp) * 2], ci = Cc[((dir * 16 + c) * 64 + pp) * 2 + 1];
            const float br = Bb[((dir * 64 + pp) * 16 + c2) * 2], bi = Bb[((dir * 64 + pp) * 16 + c2) * 2 + 1];
            const float wr = cr * ar - ci * ai, wi = cr * ai + ci * ar;
            acc += wr * br - wi * bi;
        }
        Kt[idx] = acc;
    }
    bf16_t* bty = (bf16_t*)((unsigned char*)p.out + DO_BTY) + (size_t)g * 256 * 512;
    bf16_t* bts = (bf16_t*)((unsigned char*)p.out + DO_BTS) + (size_t)g * 256 * 256;
    for (int idx = tid; idx < 65536; idx += 512) {
        const int n = idx >> 8, kk = idx & 255, t = n >> 4, c = n & 15, dir = kk >> 7, reim = (kk >> 6) & 1, pp = kk & 63;
        const int j = dir == 0 ? t + 1 : 16 - t;
        const float ar = apow[((dir * 17 + j) * 64 + pp) * 2], ai = apow[((dir * 17 + j) * 64 + pp) * 2 + 1];
        const float cr = Cc[((dir * 16 + c) * 64 + pp) * 2], ci = Cc[((dir * 16 + c) * 64 + pp) * 2 + 1];
        const float wr = cr * ar - ci * ai, wi = cr * ai + ci * ar;
        bty[n * 512 + 256 + kk] = f2bf(reim == 0 ? wr : -wi);
    }
    for (int idx = tid; idx < 65536; idx += 512) {
        const int n = idx >> 8, kk = idx & 255, dir = n >> 7, reim = (n >> 6) & 1, pp = n & 63, s = kk >> 4, c2 = kk & 15;
        const int j = dir == 0 ? 15 - s : s;
        const float ar = apow[((dir * 17 + j) * 64 + pp) * 2], ai = apow[((dir * 17 + j) * 64 + pp) * 2 + 1];
        const float br = Bb[((dir * 64 + pp) * 16 + c2) * 2], bi = Bb[((dir * 64 + pp) * 16 + c2) * 2 + 1];
        const float wr = ar * br - ai * bi, wi = ar * bi + ai * br;
        bts[n * 256 + kk] = f2bf(reim == 0 ? wr : wi);
    }
    __syncthreads();
    for (int idx = tid; idx < 65536; idx += 512) {
        const int n = idx >> 8, kk = idx & 255, t = n >> 4, c = n & 15, s = kk >> 4, c2 = kk & 15;
        float v = 0.f;
        if (s <= t) v += Kt[(((t - s)) * 16 + c) * 16 + c2];
        if (s >= t) v += Kt[((16 + (s - t)) * 16 + c) * 16 + c2];
        if (s == t && c == c2) v += dskip[g * 16 + c];
        bty[n * 512 + kk] = f2bf(v);
    }
    __syncthreads();
}

__device__ __forceinline__ int t5_bucket(int rel) {
    const int ret = rel > 0 ? 16 : 0; const int n = rel < 0 ? -rel : rel;
    if (n < 8) return ret + n;
    int large = 8 + (int)(logf((float)n / 8.0f) / 4.852030263919617f * 8.0f);
    large = large < 15 ? large : 15;
    return ret + large;
}

constexpr int RMS_NR = 4;
template <bool OUT_BF16>
__device__ __forceinline__ void rms_rows(const float* s0, const float* s1, const float* gam, void* dst, int G) {
    const int tid_ = ltid(); const int lane = tid_ & 63, gw = blockIdx.x * 8 + (tid_ >> 6), nw = G * 8;
    for (int r0 = gw; r0 < M_TOK; r0 += RMS_NR * nw) {
        f32x4 v[RMS_NR][8]; float ss[RMS_NR];
#pragma unroll
        for (int q = 0; q < RMS_NR; ++q) {
            const int r = r0 + q * nw, rc = r < M_TOK ? r : r0;
            const float* src = (s1 != nullptr && rc >= 32768) ? s1 + (size_t)(rc - 32768) * DM : s0 + (size_t)rc * DM;
#pragma unroll
            for (int j = 0; j < 8; ++j) v[q][j] = *(const f32x4*)(src + (j * 64 + lane) * 4);
        }
#pragma unroll
        for (int q = 0; q < RMS_NR; ++q) { float a = 0.f;
#pragma unroll
            for (int j = 0; j < 8; ++j) a += v[q][j][0] * v[q][j][0] + v[q][j][1] * v[q][j][1] + v[q][j][2] * v[q][j][2] + v[q][j][3] * v[q][j][3];
#pragma unroll
            for (int o = 32; o >= 1; o >>= 1) a += __shfl_xor(a, o);
            ss[q] = rsqrtf(a * (1.0f / DM) + 1e-6f); }
#pragma unroll
        for (int j = 0; j < 8; ++j) {
            const f32x4 gg = *(const f32x4*)(gam + (j * 64 + lane) * 4);
#pragma unroll
            for (int q = 0; q < RMS_NR; ++q) {
                const int r = r0 + q * nw; if (r >= M_TOK) continue;
                const f32x4 y = v[q][j] * ss[q] * gg;
                if constexpr (OUT_BF16) { u32x2 w; w.x = cvt_pk_bf16(y[0], y[1]); w.y = cvt_pk_bf16(y[2], y[3]); *(u32x2*)((bf16_t*)dst + (size_t)r * DM + (j * 64 + lane) * 4) = w; }
                else *(f32x4*)((float*)dst + (size_t)r * DM + (j * 64 + lane) * 4) = y;
            }
        }
    }
}

template <bool OUT_BF16>
__device__ __forceinline__ void rms_rows_b16(const bf16_t* src, const float* gam, void* dst, int G) {
    const int tid_ = ltid(); const int lane = tid_ & 63, gw = blockIdx.x * 8 + (tid_ >> 6), nw = G * 8;
    for (int r0 = gw; r0 < M_TOK; r0 += RMS_NR * nw) {
        u32x4 v[RMS_NR][4]; float ss[RMS_NR];
#pragma unroll
        for (int q = 0; q < RMS_NR; ++q) {
            const int r = r0 + q * nw, rc = r < M_TOK ? r : r0;
#pragma unroll
            for (int j = 0; j < 4; ++j) v[q][j] = *(const u32x4*)(src + (size_t)rc * DM + (j * 64 + lane) * 8);
        }
#pragma unroll
        for (int q = 0; q < RMS_NR; ++q) { float a = 0.f;
#pragma unroll
            for (int j = 0; j < 4; ++j) { f32x4 x0, x1; unpack8(v[q][j], x0, x1); a += (x0[0] * x0[0] + x0[1] * x0[1]) + (x0[2] * x0[2] + x0[3] * x0[3]) + (x1[0] * x1[0] + x1[1] * x1[1]) + (x1[2] * x1[2] + x1[3] * x1[3]); }
#pragma unroll
            for (int o = 32; o >= 1; o >>= 1) a += __shfl_xor(a, o);
            ss[q] = rsqrtf(a * (1.0f / DM) + 1e-6f); }
#pragma unroll
        for (int j = 0; j < 4; ++j) {
            const f32x4 g0 = *(const f32x4*)(gam + (j * 64 + lane) * 8), g1 = *(const f32x4*)(gam + (j * 64 + lane) * 8 + 4);
#pragma unroll
            for (int q = 0; q < RMS_NR; ++q) {
                const int r = r0 + q * nw; if (r >= M_TOK) continue;
                f32x4 x0, x1; unpack8(v[q][j], x0, x1);
                const f32x4 y0 = x0 * ss[q] * g0, y1 = x1 * ss[q] * g1;
                if constexpr (OUT_BF16) *(u32x4*)((bf16_t*)dst + (size_t)r * DM + (j * 64 + lane) * 8) = pack8(y0, y1);
                else { float* d = (float*)dst + (size_t)r * DM + (j * 64 + lane) * 8; *(f32x4*)d = y0; *(f32x4*)(d + 4) = y1; }
            }
        }
    }
}

__device__ __forceinline__ void rowss_pass(const bf16_t* src, float* rs2, int G) {
    const int tid_ = ltid(); const int lane = tid_ & 63, gw = blockIdx.x * 8 + (tid_ >> 6), nw = G * 8;
    for (int r0 = gw; r0 < M_TOK; r0 += 8 * nw) {
        u32x4 v[8][4];
#pragma unroll
        for (int q = 0; q < 8; ++q) { const int r = r0 + q * nw, rc = r < M_TOK ? r : r0;
#pragma unroll
            for (int j = 0; j < 4; ++j) v[q][j] = *(const u32x4*)(src + (size_t)rc * DM + (j * 64 + lane) * 8); }
#pragma unroll
        for (int q = 0; q < 8; ++q) { float a = 0.f;
#pragma unroll
            for (int j = 0; j < 4; ++j) { f32x4 x0, x1; unpack8(v[q][j], x0, x1); a += (x0[0] * x0[0] + x0[1] * x0[1]) + (x0[2] * x0[2] + x0[3] * x0[3]) + (x1[0] * x1[0] + x1[1] * x1[1]) + (x1[2] * x1[2] + x1[3] * x1[3]); }
#pragma unroll
            for (int o = 32; o >= 1; o >>= 1) a += __shfl_xor(a, o);
            const int r = r0 + q * nw; if (lane == 0 && r < M_TOK) rs2[r] = 1.0f / (a * (1.0f / DM) + 1e-6f); }
    }
}

__device__ __forceinline__ void prep_phase(LAS unsigned char* lds, const Params& p, int G) {
    const int tid = ltid();
    for (int g = blockIdx.x; g < 64; g += G) ssm_prep(lds, p, g);
    if ((int)blockIdx.x == G - 1) {
        float* bt = (float*)(p.ws + WS_BIAS); const float* rb = p.in[20];
        for (int idx = tid; idx < 12 * 129; idx += 512) { const int head = idx / 129, ri = idx % 129, d = 1 << (2 * (head >> 2));
            bt[head * 132 + ri] = rb[t5_bucket((ri - 64) * d) * 12 + head] * 1.4426950408889634f; }
    }
    {
        const float* srcs[7] = {p.in[3], p.in[12], p.in[14], p.in[15], p.in[16], p.in[18], p.in[19]};
        const size_t dofs[7] = {DO_WIN, DO_WGLU, DO_WBS, DO_WBA, DO_WOUT, DO_WFF1, DO_WFF2};
        const int Ks[7] = {2048, 1024, 1024, 512, 2048, 2048, 8192}, Ns[7] = {9728, 1024, 2048, 2048, 2048, 8192, 2048};
        LAS float* tl = (LAS float*)lds;
        int total = 0;
#pragma unroll
        for (int w = 0; w < 7; ++w) total += (Ks[w] / 64) * (Ns[w] / 64);
        const int tskew = G > 128 ? 64 : 0;
        for (int tile0 = (int)blockIdx.x - tskew; tile0 < total; tile0 += 2 * (G - tskew)) {
            if (tile0 < 0) break;
            float ld[2][8]; bf16_t* dsts[2]; int Kq[2], k0q[2], n0q[2]; bool okq[2];
#pragma unroll
            for (int q = 0; q < 2; ++q) {
                const int tile = tile0 + q * (G - tskew); okq[q] = tile < total;
                int w = 0, tt = okq[q] ? tile : tile0; const float* src = srcs[0]; size_t dof = dofs[0]; int K = Ks[0], N = Ns[0];
#pragma unroll
                for (int qq = 0; qq < 6; ++qq) { const int cnt = (Ks[qq] / 64) * (Ns[qq] / 64); if (w == qq && tt >= cnt) { tt -= cnt; w = qq + 1; src = srcs[qq + 1]; dof = dofs[qq + 1]; K = Ks[qq + 1]; N = Ns[qq + 1]; } }
                const int ntn = N / 64, k0 = (tt / ntn) * 64, n0 = (tt % ntn) * 64;
                dsts[q] = (bf16_t*)((unsigned char*)p.out + dof); Kq[q] = K; k0q[q] = k0; n0q[q] = n0;
                const int j = tid & 63, i0 = tid >> 6;
#pragma unroll
                for (int ii = 0; ii < 8; ++ii) { const int i = i0 + 8 * ii; ld[q][ii] = src[(size_t)(k0 + i) * N + n0 + j] * ((w == 5) ? p.in[17][k0 + i] : 1.0f); }
            }
#pragma unroll
            for (int q = 0; q < 2; ++q) { const int j = tid & 63, i0 = tid >> 6;
#pragma unroll
                for (int ii = 0; ii < 8; ++ii) { const int i = i0 + 8 * ii; tl[q * 64 * 65 + i * 65 + j] = ld[q][ii]; } }
            __syncthreads();
#pragma unroll
            for (int q = 0; q < 2; ++q) { if (!okq[q]) continue; const int kp = tid & 31, nn0 = tid >> 5;
#pragma unroll
                for (int jj = 0; jj < 4; ++jj) { const int nn = nn0 + 16 * jj;
                    *(unsigned*)(dsts[q] + (size_t)(n0q[q] + nn) * Kq[q] + k0q[q] + 2 * kp) = cvt_pk_bf16(tl[q * 64 * 65 + (2 * kp) * 65 + nn], tl[q * 64 * 65 + (2 * kp + 1) * 65 + nn]); } }
            __syncthreads();
        }
    }
    rms_rows<true>(p.in[0], p.in[1], p.in[2], (void*)((unsigned char*)p.out + DO_XN), G);
}

constexpr int VS_PITCH = 288, VS_ROWS = 208, VS_BYTES = VS_ROWS * VS_PITCH;
struct AttnItem { int head, dsh, r, pos0, seq_base, m, i0; };
__device__ __forceinline__ AttnItem attn_item(int it) {
    AttnItem a; a.head = it / 768; const int pb = it - a.head * 768, gi = a.head >> 2; a.dsh = gi * 2;
    const int p0 = pb * 64; int lsh; if (p0 < 32768) { a.seq_base = p0 & ~8191; lsh = 13; } else { a.seq_base = 32768; lsh = 14; }
    const int lm = lsh - a.dsh; a.m = 1 << lm; const int local = p0 - a.seq_base; a.r = local >> lm; a.i0 = local - (a.r << lm);
    a.pos0 = a.seq_base + (a.i0 << a.dsh); return a;
}
__device__ __forceinline__ int attn_pair(int j, int c, int G) {
    if ((G & 7) == 0 && (4608 % G) == 0) { const int per_xcd = 4608 / 8, wpx = G >> 3; return (c & 7) * per_xcd + j * wpx + (c >> 3); }
    return j * G + c;
}
__device__ __forceinline__ void attn_load_v(const AttnItem& a, const bf16_t* qkv, int ht, u32x4 (&vreg)[12]) {
#pragma unroll
    for (int pass = 0; pass < 12; ++pass) {
        const int row = pass * 16 + (ht >> 4), ch = ht & 15, ki = a.i0 - 64 + row;
        u32x4 val = (u32x4){0u, 0u, 0u, 0u};
        if (ki >= 0 && ki < a.m) val = *(const u32x4*)(qkv + ((size_t)(24 + a.head) * M_TOK + a.seq_base + a.r * a.m + ki) * 128 + ch * 8);
        vreg[pass] = val;
    }
}
template <bool EDGE>
__device__ __forceinline__ float attn_scores(f32x4 (&sa)[10], const LAS float* bsl, int dl, int kabs0, int m, float scale2) {
    float mx = -3.0e38f;
#pragma unroll
    for (int t9 = 0; t9 < 9; ++t9)
#pragma unroll
        for (int j = 0; j < 4; ++j) {
            bool valid = true;
            if (t9 == 0) valid = (j + dl >= 0);
            if (t9 == 8) valid = (j + dl <= 0);
            if (EDGE) { const int kabs = kabs0 + 16 * t9 + j; valid = valid && (kabs >= 0) && (kabs < m); }
            float sv = sa[t9][j] * scale2 + bsl[16 * t9 + j];
            sv = valid ? sv : -1.0e30f;
            sa[t9][j] = sv; mx = fmaxf(mx, sv);
        }
    return mx;
}
__device__ __forceinline__ void attn_phase(LAS unsigned char* lds, bf16_t* qkv, float* lse, const float* biasT, int G) {
    const int tid = ltid(), wave = __builtin_amdgcn_readfirstlane(tid >> 6), lane = tid & 63, half = wave >> 2, w4 = wave & 3, li = lane & 15, lg = lane >> 4, ht = tid & 255;
    LAS unsigned char* vs = lds + half * VS_BYTES;
    LAS float* bs = (LAS float*)(lds + 2 * VS_BYTES + half * 1024);
    const float scale2 = 0.08838834764831845f * 1.4426950408889634f;
    for (int i = ht; i < 16 * VS_PITCH / 16; i += 256) *(LAS u32x4*)(vs + 192 * VS_PITCH + i * 16) = (u32x4){0u, 0u, 0u, 0u};
    if (ht < 176) bs[ht] = 0.f;
    const int dl = 4 * lg - li, q4 = li >> 2, p4 = li & 3;
    const LAS float* bsl = bs + 16 + dl;
    const LAS unsigned char* vrd = vs + (16 * w4 + 4 * lg + q4) * VS_PITCH + (4 * p4) * 2;
    u32x4 vreg[12];
    const int nrounds = (4608 + G - 1) / G, cwg = blockIdx.x;
    { const int pair0 = attn_pair(0, cwg, G); if (pair0 < 4608) { const AttnItem a = attn_item(pair0 * 2 + half); attn_load_v(a, qkv, ht, vreg); } }
    __syncthreads();
    for (int j = 0; j < nrounds; ++j) {
        const int pair = attn_pair(j, cwg, G); if (pair >= 4608) break;
        const int pairn = (j + 1 < nrounds) ? attn_pair(j + 1, cwg, G) : 4608;
        const AttnItem a = attn_item(pair * 2 + half);
#pragma unroll
        for (int pass = 0; pass < 12; ++pass) *(LAS u32x4*)(vs + (pass * 16 + (ht >> 4)) * VS_PITCH + (ht & 15) * 16) = vreg[pass];
        if (ht < 129) bs[16 + ht] = biasT[a.head * 132 + ht];
        __syncthreads();
        const size_t tokq = (size_t)(a.pos0 + a.r + ((16 * w4 + li) << a.dsh));
        const int pbase = a.seq_base + a.r * a.m;
        bf16_t* qp = qkv + ((size_t)a.head * M_TOK + pbase + a.i0 + 16 * w4 + li) * 128;
        bf16x8 Qf[4];
#pragma unroll
        for (int ks = 0; ks < 4; ++ks) Qf[ks] = *(const bf16x8*)(qp + 32 * ks + 8 * lg);
        const int kbase = a.i0 - 64 + 16 * w4 + li;
        const bf16_t* kcol = qkv + ((size_t)(12 + a.head) * M_TOK + pbase) * 128 + 8 * lg;
        f32x4 sa[10];
        bf16x8 Kf[2][3][4];
#define ATT_LOADK(buf, grp) do { _Pragma("unroll") for (int tt = 0; tt < 3; ++tt) { int ki = kbase + 16 * ((grp) * 3 + tt); ki = ki < 0 ? 0 : (ki > a.m - 1 ? a.m - 1 : ki); \
            const bf16_t* kp = kcol + (size_t)ki * 128; \
            _Pragma("unroll") for (int ks = 0; ks < 4; ++ks) Kf[buf][tt][ks] = *(const bf16x8*)(kp + 32 * ks); } } while (0)
#define ATT_MMAK(buf, grp) do { _Pragma("unroll") for (int tt = 0; tt < 3; ++tt) { f32x4 acc_ = (f32x4){0.f, 0.f, 0.f, 0.f}; \
            _Pragma("unroll") for (int ks = 0; ks < 4; ++ks) acc_ = __builtin_amdgcn_mfma_f32_16x16x32_bf16(Kf[buf][tt][ks], Qf[ks], acc_, 0, 0, 0); sa[(grp) * 3 + tt] = acc_; } } while (0)
        ATT_LOADK(0, 0); ATT_LOADK(1, 1);
        __builtin_amdgcn_sched_barrier(0);
        ATT_MMAK(0, 0);
        __builtin_amdgcn_sched_barrier(0);
        ATT_LOADK(0, 2);
        if (pairn < 4608) { const AttnItem an = attn_item(pairn * 2 + half); attn_load_v(an, qkv, ht, vreg); }
        __builtin_amdgcn_sched_barrier(0);
        ATT_MMAK(1, 1);
        ATT_MMAK(0, 2);
#undef ATT_LOADK
#undef ATT_MMAK
        sa[9] = (f32x4){0.f, 0.f, 0.f, 0.f};
        const int kabs0 = a.i0 - 64 + 16 * w4 + 4 * lg;
        const bool edge = (a.i0 == 0) || (a.i0 + 64 == a.m);
        float mx = edge ? attn_scores<true>(sa, bsl, dl, kabs0, a.m, scale2) : attn_scores<false>(sa, bsl, dl, kabs0, a.m, scale2);
        mx = fmaxf(mx, __shfl_xor(mx, 16)); mx = fmaxf(mx, __shfl_xor(mx, 32));
        float sum = 0.f;
#pragma unroll
        for (int t9 = 0; t9 < 9; ++t9)
#pragma unroll
            for (int j = 0; j < 4; ++j) { const float pv = __builtin_amdgcn_exp2f(sa[t9][j] - mx); sa[t9][j] = pv; sum += pv; }
        sum += __shfl_xor(sum, 16); sum += __shfl_xor(sum, 32);
        bf16x8 Pf[5];
#pragma unroll
        for (int s5 = 0; s5 < 5; ++s5) {
            u32x4 w; w.x = cvt_pk_bf16(sa[2 * s5][0], sa[2 * s5][1]); w.y = cvt_pk_bf16(sa[2 * s5][2], sa[2 * s5][3]);
            w.z = cvt_pk_bf16(sa[2 * s5 + 1][0], sa[2 * s5 + 1][1]); w.w = cvt_pk_bf16(sa[2 * s5 + 1][2], sa[2 * s5 + 1][3]);
            Pf[s5] = __builtin_bit_cast(bf16x8, w);
        }
        const float inv = 1.0f / sum;
        f32x4 o[8];
#pragma unroll
        for (int dt = 0; dt < 8; ++dt) o[dt] = (f32x4){0.f, 0.f, 0.f, 0.f};
#pragma unroll
        for (int s5 = 0; s5 < 5; ++s5) {
            s16x4 va[8], vb[8];
#pragma unroll
            for (int dt = 0; dt < 8; ++dt) {
                va[dt] = __builtin_amdgcn_ds_read_tr16_b64_v4i16((LAS s16x4*)(vrd + (32 * s5) * VS_PITCH + 32 * dt));
                vb[dt] = __builtin_amdgcn_ds_read_tr16_b64_v4i16((LAS s16x4*)(vrd + (32 * s5 + 16) * VS_PITCH + 32 * dt));
            }
#pragma unroll
            for (int dt = 0; dt < 8; ++dt) {
                const bf16x8 Vf = (bf16x8){va[dt][0], va[dt][1], va[dt][2], va[dt][3], vb[dt][0], vb[dt][1], vb[dt][2], vb[dt][3]};
                o[dt] = __builtin_amdgcn_mfma_f32_16x16x32_bf16(Vf, Pf[s5], o[dt], 0, 0, 0);
            }
        }
#pragma unroll
        for (int dt = 0; dt < 8; ++dt) {
            const f32x4 ov = o[dt] * inv;
            u32x2 w; w.x = cvt_pk_bf16(ov[0], ov[1]); w.y = cvt_pk_bf16(ov[2], ov[3]);
            *(u32x2*)(qp + 16 * dt + 4 * lg) = w;
        }
        if (lg == 0) lse[tokq * 12 + a.head] = (mx + __log2f(sum)) * 0.6931471805599453f;
        __syncthreads();
    }
}

__device__ __forceinline__ void scan_merge_phase(const Params& p, int G) {
    const int tid = ltid(), lane = tid & 63;
    const bf16_t* S = (const bf16_t*)((unsigned char*)p.out + DO_XN);
    bf16_t* assm = (bf16_t*)(p.ws + WS_ASSM);
    for (int item = (tid >> 6) * G + blockIdx.x; item < 640; item += 8 * G) {
        const int g = item & 63, dir = (item >> 6) & 1, seq = item >> 7;
        const int n0 = seq < 4 ? seq * 512 : 2048, len = seq < 4 ? 512 : 1024;
        const float are = p.in[4][(dir * 64 + g) * 64 + lane], aim = p.in[5][(dir * 64 + g) * 64 + lane], dt = expf(p.in[6][dir * 64 + g]);
        const float mag = expf(16.0f * are * dt); float sn, cs; sincosf(16.0f * aim * dt, &sn, &cs);
        const float ar = mag * cs, ai = mag * sn;
        float hr = 0.f, hi = 0.f;
        const int nstart = dir == 0 ? n0 : n0 + len - 1; const long step = dir == 0 ? 1 : -1;
        const bf16_t* Sp = S + ((size_t)g * NCHUNK + nstart) * 256 + dir * 128 + lane;
        bf16_t* Ap = assm + ((size_t)g * NCHUNK + nstart) * 512 + 256 + dir * 128 + lane;
        const long sS = step * 256, sA = step * 512;
        float sr[2][16], si[2][16];
#define SCAN_LOAD(buf, b) do { _Pragma("unroll") for (int k = 0; k < 16; ++k) { sr[buf][k] = __uint_as_float((unsigned)Sp[((b) + k) * sS] << 16); si[buf][k] = __uint_as_float((unsigned)Sp[((b) + k) * sS + 64] << 16); } } while (0)
#define SCAN_STEP(buf, b) do { _Pragma("unroll") for (int k = 0; k < 16; ++k) { Ap[((b) + k) * sA] = f2bf(hr); Ap[((b) + k) * sA + 64] = f2bf(hi); \
            const float nr = ar * hr - ai * hi + sr[buf][k], ni = ar * hi + ai * hr + si[buf][k]; hr = nr; hi = ni; } } while (0)
        SCAN_LOAD(0, 0);
        for (int b = 0; b < len; b += 32) {
            SCAN_LOAD(1, b + 16);
            SCAN_STEP(0, b);
            if (b + 32 < len) SCAN_LOAD(0, b + 32);
            SCAN_STEP(1, b + 16);
        }
#undef SCAN_LOAD
#undef SCAN_STEP
    }
    const bf16_t* o = (const bf16_t*)(p.ws + WS_QKV); const float* lse = (const float*)(p.ws + WS_LSE);
    bf16_t* ya = (bf16_t*)((unsigned char*)p.out + DO_YATT);
    for (int idx0 = blockIdx.x * 512 + tid; idx0 < M_TOK * 64; idx0 += 2 * G * 512) {
        f32x4 a0[2], a1[2], b0[2], b1[2], c0[2], c1[2]; float w0[2], w1[2], w2[2];
#pragma unroll
        for (int q = 0; q < 2; ++q) {
            const int idx = idx0 + q * G * 512 < M_TOK * 64 ? idx0 + q * G * 512 : idx0;
            const int tok = idx >> 6, hh = (idx >> 4) & 3, ch = idx & 15;
            const float l0 = lse[tok * 12 + hh], l1 = lse[tok * 12 + 4 + hh], l2 = lse[tok * 12 + 8 + hh];
            int sbase, lsh; if (tok < 32768) { sbase = tok & ~8191; lsh = 13; } else { sbase = 32768; lsh = 14; }
            const int local = tok - sbase;
            const int p1 = sbase + ((local & 3) << (lsh - 2)) + (local >> 2), p2 = sbase + ((local & 15) << (lsh - 4)) + (local >> 4);
            unpack8(*(const u32x4*)(o + ((size_t)hh * M_TOK + tok) * 128 + ch * 8), a0[q], a1[q]);
            unpack8(*(const u32x4*)(o + ((size_t)(4 + hh) * M_TOK + p1) * 128 + ch * 8), b0[q], b1[q]);
            unpack8(*(const u32x4*)(o + ((size_t)(8 + hh) * M_TOK + p2) * 128 + ch * 8), c0[q], c1[q]);
            const float mx = fmaxf(l0, fmaxf(l1, l2)); w0[q] = __expf(l0 - mx); w1[q] = __expf(l1 - mx); w2[q] = __expf(l2 - mx);
            const float inv = 1.0f / (w0[q] + w1[q] + w2[q]); w0[q] *= inv; w1[q] *= inv; w2[q] *= inv;
        }
#pragma unroll
        for (int q = 0; q < 2; ++q) {
            const int idx = idx0 + q * G * 512; if (idx >= M_TOK * 64) continue;
            const int tok = idx >> 6, hh = (idx >> 4) & 3, ch = idx & 15;
            *(u32x4*)(ya + (size_t)tok * 512 + hh * 128 + ch * 8) = pack8(a0[q] * w0[q] + b0[q] * w1[q] + c0[q] * w2[q], a1[q] * w0[q] + b1[q] * w1[q] + c1[q] * w2[q]);
        }
    }
}

template <bool COOP>
__global__ void __launch_bounds__(512, 2) fwd_kernel(Params p) {
    extern __shared__ __attribute__((aligned(16))) unsigned char lds_raw[];
    LAS unsigned char* lds = (LAS unsigned char*)lds_raw;
    const int G = gridDim.x;
    XcdBarrier xb; xb.bar = (unsigned*)(p.ws + WS_BAR); xb.x = 0; xb.st = (volatile LAS unsigned*)(lds + 131072);
    bool posted = false;
    if constexpr (COOP) {
        if (threadIdx.x < 4) ((LAS unsigned*)(lds + 131072))[threadIdx.x] = 0u;
        if (blockIdx.x == 0) for (int i = threadIdx.x; i < XCD_BAR_WORDS; i += 512) __hip_atomic_store(xb.bar + i, 0u, __ATOMIC_RELAXED, __HIP_MEMORY_SCOPE_AGENT);
        __syncthreads();
    }
    for (int ph = p.ph_lo; ph < p.ph_hi; ++ph)
    for (int rep = 0; rep < (((PROBE_MASK >> ph) & 1u) ? 2 : 1); ++rep) {
        if ((ph > p.ph_lo || rep > 0) && !(COOP && ph == 7)) { if constexpr (COOP) {
            if (!posted) { cg::this_grid().sync(); xb = xcd_barrier_post((unsigned*)(p.ws + WS_BAR), (volatile LAS unsigned*)(lds + 131072)); posted = true; }
            else xcd_barrier(xb);
        } }
        unsigned char* ws = lptr(p.ws); unsigned char* dob = lptr((unsigned char*)p.out);
        const bf16_t* hb16 = (const bf16_t*)(ws + WS_GATES); const bf16_t* hfin16 = hb16 + (size_t)M_TOK * DM;
        if (ph == 0) { prep_phase(lds, p, G); continue; }
        if (ph == 3) { scan_merge_phase(p, G); continue; }
        if (ph == 9) rowss_pass(hb16, (float*)(ws + WS_RS2), G);
        if (ph == N_PHASES - 1) { rms_rows_b16<false>(hfin16, p.in[21], (void*)p.out, G); continue; }
        bf16_t* assm = (bf16_t*)(ws + WS_ASSM); bf16_t* z = (bf16_t*)(dob + DO_XN);
        pg8::GemmD g; pg8::Sched S; pg8::Epi E;
        E.ws = ws; E.dob = dob; E.bglu = p.in[13]; E.x0 = p.in[0]; E.x1 = p.in[1]; E.hoff = 0; E.roff = 0;
        S.G = G; S.c = blockIdx.x; S.ssm = 0; S.nM = M_TOK / 256;
        if (ph == 1) { g = {z, (const bf16_t*)(dob + DO_WIN), DM, DM, DM}; S.nN = 38; E.mode = pg8::EM_INPROJ; }
        else if (ph == 2) { g = {assm, (const bf16_t*)(dob + DO_BTS), 512, 256, 256}; S.ssm = 1; S.nM = 768; S.nN = 1; E.mode = pg8::EM_SSM_S; }
        else if (ph == 4) { g = {assm, (const bf16_t*)(dob + DO_BTY), 512, 512, 512}; S.ssm = 1; S.nM = 768; S.nN = 1; E.mode = pg8::EM_SSM_Y; }
        else if (ph == 5) { g = {z, (const bf16_t*)(dob + DO_WGLU), SSMW, SSMW, SSMW}; S.nN = 4; E.mode = pg8::EM_GLU; }
        else if (ph == 6) { g = {z + (size_t)M_TOK * SSMW, (const bf16_t*)(dob + DO_WBS), SSMW, SSMW, SSMW}; S.nN = 8; E.mode = pg8::EM_BR1; }
        else if (ph == 7) { g = {(const bf16_t*)(dob + DO_YATT), (const bf16_t*)(dob + DO_WBA), 512, 512, 512}; S.nN = 8; E.mode = pg8::EM_BR2; }
        else if (ph == 8) { g = {(const bf16_t*)(ws + WS_QKV), (const bf16_t*)(dob + DO_WOUT), DM, DM, DM}; S.nN = 8; E.mode = pg8::EM_OUT; }
        else {
            const int c = (ph - 9) >> 1;
            if (((ph - 9) & 1) == 0) { g = {hb16 + (size_t)c * FF_ROWS * DM, (const bf16_t*)(dob + DO_WFF1), DM, DM, DM}; S.nM = FF_ROWS / 256; S.nN = 32; E.mode = pg8::EM_FF1; }
            else { g = {(const bf16_t*)(ws + WS_QKV), (const bf16_t*)(dob + DO_WFF2), DFF, DFF, DFF}; S.nM = FF_ROWS / 256; S.nN = 8; E.mode = pg8::EM_FF2; E.hoff = (size_t)c * FF_ROWS * DM; E.roff = c * FF_ROWS; }
        }
        S.nwg = S.nM * S.nN;
        pg8::gemm_phase(lds, g, S, E);
        if (ph == 2) attn_phase(lds, (bf16_t*)(ws + WS_QKV), (float*)(ws + WS_LSE), (const float*)(ws + WS_BIAS), G);
    }
}

extern "C" void kernel_launch(void* const* d_in, const int* in_sizes, int n_in, void* d_out, int out_size, void* d_ws, size_t ws_size, hipStream_t stream) {
    static int grid = 0;
    if (grid == 0) {
        if (n_in != 22 || out_size != M_TOK * DM || ws_size < WS_END) { fprintf(stderr, "kernel_launch: unexpected shapes (n_in %d, out %d, ws %zu, need %zu)\n", n_in, out_size, ws_size, (size_t)WS_END); grid = -1; return; }
        int dev = 0, cus = 0, per_cu = 0;
        (void)hipGetDevice(&dev); (void)hipDeviceGetAttribute(&cus, hipDeviceAttributeMultiprocessorCount, dev);
        (void)hipFuncSetAttribute((const void*)fwd_kernel<true>, hipFuncAttributeMaxDynamicSharedMemorySize, LDS_BYTES);
        (void)hipFuncSetAttribute((const void*)fwd_kernel<false>, hipFuncAttributeMaxDynamicSharedMemorySize, LDS_BYTES);
        (void)hipOccupancyMaxActiveBlocksPerMultiprocessor(&per_cu, (const void*)fwd_kernel<true>, 512, LDS_BYTES);
        if (per_cu < 1) per_cu = 1;
        (void)hipGetLastError();
        grid = cus * per_cu; if (grid > 256) grid = 256; if (grid < 1) grid = 256;
    }
    if (grid < 0) return;
    Params p{};
    for (int i = 0; i < 22; ++i) p.in[i] = (const float*)d_in[i];
    p.out = (float*)d_out; p.ws = (unsigned char*)d_ws;
#if MK_COOP
    p.ph_lo = 0; p.ph_hi = N_PHASES;
    void* args[] = {&p};
    hipError_t e = hipLaunchCooperativeKernel((const void*)fwd_kernel<true>, dim3(grid), dim3(512), args, LDS_BYTES, stream);
    if (e != hipSuccess) fprintf(stderr, "cooperative launch failed: %s (grid %d)\n", hipGetErrorString(e), grid);
#else
    for (int ph = 0; ph < N_PHASES; ++ph) {
        p.ph_lo = ph; p.ph_hi = ph + 1;
        hipLaunchKernelGGL(fwd_kernel<false>, dim3(grid), dim3(512), LDS_BYTES, stream, p);
    }
#endif
}
```

```cpp
#include <hip/hip_runtime.h>
#include <hip/hip_cooperative_groups.h>
#include <cstdio>
#include <cstdint>
namespace cg = cooperative_groups;

#ifndef MK_COOP
#define MK_COOP 1
#endif

#ifndef PROBE_MASK
#define PROBE_MASK 0u
#endif
#define LAS __attribute__((address_space(3)))
typedef unsigned short bf16_t;
typedef short bf16x8 __attribute__((ext_vector_type(8)));
typedef short s16x4 __attribute__((ext_vector_type(4)));
typedef float f32x4 __attribute__((ext_vector_type(4)));
typedef unsigned u32x4 __attribute__((ext_vector_type(4)));
typedef unsigned u32x2 __attribute__((ext_vector_type(2)));

constexpr int M_TOK = 49152, DM = 2048, SSMW = 1024, QKVW = 4608, GATEW = 4096, DFF = 8192;
constexpr int NCHUNK = M_TOK / 16;
constexpr int FF_ROWS = 24576, N_FFC = 2;
constexpr int N_PHASES = 9 + 2 * N_FFC + 1;
constexpr int LDS_BYTES = 131072 + 16;

constexpr size_t WS_ASSM = 0;
constexpr size_t WS_QKV = 201326592;
constexpr size_t WS_GATES = WS_QKV + 452984832;
constexpr size_t WS_LSE = WS_GATES + 402653184;
constexpr size_t WS_BIAS = WS_LSE + 2359296;
constexpr size_t WS_BAR = WS_BIAS + 8192;
constexpr size_t WS_RS2 = WS_BAR + 16384;
constexpr size_t WS_END = WS_RS2 + 196608;
constexpr size_t DO_WIN = 0, DO_WGLU = 39845888, DO_WBS = 41943040, DO_WBA = 46137344, DO_WOUT = 48234496, DO_WFF1 = 56623104, DO_WFF2 = 90177536;
constexpr size_t DO_BTY = 123731968;
constexpr size_t DO_BTS = 140509184;
constexpr size_t DO_XN = 148897792;
constexpr size_t DO_YATT = 350224384;

typedef __bf16 bf16x2_t __attribute__((ext_vector_type(2)));
typedef float f32x2_t __attribute__((ext_vector_type(2)));
__device__ __forceinline__ unsigned cvt_pk_bf16(float lo, float hi) { const bf16x2_t r = __builtin_convertvector((f32x2_t){lo, hi}, bf16x2_t); return __builtin_bit_cast(unsigned, r); }
__device__ __forceinline__ bf16_t f2bf(float f) { unsigned u = __float_as_uint(f); u += 0x7FFFu + ((u >> 16) & 1u); return (bf16_t)(u >> 16); }
__device__ __forceinline__ float bflo(unsigned w) { return __uint_as_float(w << 16); }
__device__ __forceinline__ float bfhi(unsigned w) { return __uint_as_float(w & 0xffff0000u); }
__device__ __forceinline__ void unpack8(const u32x4 w, f32x4& a, f32x4& b) { a = (f32x4){bflo(w.x), bfhi(w.x), bflo(w.y), bfhi(w.y)}; b = (f32x4){bflo(w.z), bfhi(w.z), bflo(w.w), bfhi(w.w)}; }
__device__ __forceinline__ u32x4 pack8(const f32x4 a, const f32x4 b) { u32x4 w; w.x = cvt_pk_bf16(a[0], a[1]); w.y = cvt_pk_bf16(a[2], a[3]); w.z = cvt_pk_bf16(b[0], b[1]); w.w = cvt_pk_bf16(b[2], b[3]); return w; }
__device__ __forceinline__ float sigmoidf_(float x) { return __builtin_amdgcn_rcpf(1.0f + __builtin_amdgcn_exp2f(-1.4426950408889634f * x)); }
__device__ __forceinline__ float gelu_tanh(float x) { const float y = 0.7978845608028654f * (x + 0.044715f * x * x * x); return x * __builtin_amdgcn_rcpf(1.0f + __builtin_amdgcn_exp2f(-2.8853900817779268f * y)); }

__device__ __forceinline__ int ltid() { int t = threadIdx.x; asm volatile("" : "+v"(t)); return t; }
__device__ __forceinline__ size_t opaque_zero() { size_t z = 0; asm volatile("" : "+s"(z)); return z; }
template <class T> __device__ __forceinline__ T* lptr(T* p) { return (T*)((unsigned char*)p + opaque_zero()); }
namespace pg8 {
constexpr int BM = 256, BK = 64, HALF = 128, HTB = HALF * BK * 2, NXCD = 8, WGM = 4;
__device__ __forceinline__ int lds_byte(int r, int c) { const int st = (r >> 4) * 2 + (c >> 5), rr = r & 15, cc = c & 31, ob = rr * 64 + cc * 2; return st * 1024 + (ob ^ (((ob >> 9) & 1) << 5)); }
__device__ __forceinline__ void stage_rc(int b, int& R, int& C) { const int st = b / 1024, sb = b % 1024, swz = sb ^ (((sb >> 9) & 1) << 5); R = (st >> 1) * 16 + swz / 64; C = (st & 1) * 32 + (swz % 64) / 2; }
__device__ __forceinline__ int perm32(int rho) { const int n = rho >> 4, i = rho & 15; return 8 * (i >> 2) + 4 * n + (i & 3); }

struct Unit { int pm, pn; };
struct GemmD { const bf16_t* A; const bf16_t* Bt; int lda, ldb, K; };

struct Sched {
    int nM, nN, nwg, G, c, ssm;
    __device__ __forceinline__ bool next(int i, Unit& u) const {
        const long L = (long)i * G + c; if (L >= nwg) return false;
        if (ssm) { u.pm = (int)L; u.pn = (int)L / 12; return true; }
        int wgid = (int)L; { const int q = nwg / NXCD, r = nwg % NXCD, xcd = wgid % NXCD, off = wgid / NXCD; wgid = (xcd < r ? xcd * (q + 1) : r * (q + 1) + (xcd - r) * q) + off; }
        const int nig = WGM * nN, gid = wgid / nig, fm = gid * WGM, gsz = (nM - fm) < WGM ? (nM - fm) : WGM;
        u.pm = fm + ((wgid % nig) % gsz); u.pn = (wgid % nig) / gsz; return true;
    }
};

enum { EM_INPROJ = 0, EM_SSM_S, EM_SSM_Y, EM_GLU, EM_BR1, EM_BR2, EM_OUT, EM_FF1, EM_FF2 };
struct Epi {
    int mode; unsigned char* ws; unsigned char* dob; const float* bglu; const float* x0; const float* x1; size_t hoff; int roff;
};
struct EpiP { bf16_t* assm; bf16_t* qkv; bf16_t* gates; bf16_t* S; bf16_t* z; const float* bglu; bf16_t* yssm; bf16_t* mixed; const float* x0; const float* x1; bf16_t* hb; bf16_t* hfin; bf16_t* act; const float* rs2; };

template <int MODE>
__device__ __forceinline__ void epi_body(const Epi& E0, const f32x4 (&acc)[2][2][4][2], const Unit& u, int wr, int wc, int fr, int fq) {
    asm volatile("" : "+v"(fr), "+v"(fq));
    unsigned char* ws = lptr(E0.ws); unsigned char* dob = lptr(E0.dob);
    EpiP E;
    E.assm = (bf16_t*)(ws + WS_ASSM); E.qkv = (bf16_t*)(ws + WS_QKV); E.gates = (bf16_t*)(ws + WS_GATES); E.S = (bf16_t*)(dob + DO_XN); E.z = (bf16_t*)(dob + DO_XN);
    E.bglu = E0.bglu; E.yssm = E.z + (size_t)M_TOK * SSMW; E.mixed = (bf16_t*)(ws + WS_QKV); E.x0 = E0.x0; E.x1 = E0.x1; E.hb = (bf16_t*)(ws + WS_GATES) + E0.hoff; E.hfin = (bf16_t*)(ws + WS_GATES) + (size_t)M_TOK * DM + E0.hoff; E.act = (bf16_t*)(ws + WS_QKV); E.rs2 = (const float*)(ws + WS_RS2);
    const int row0 = u.pm * BM + wr * 64 + fr, cl0 = wc * 32 + 8 * fq;
#pragma unroll
    for (int ai = 0; ai < 2; ++ai)
#pragma unroll
        for (int m = 0; m < 4; ++m) {
            const int r = row0 + ai * HALF + m * 16;
            float rs2 = 1.0f;
            if constexpr (MODE == EM_FF2) rs2 = E.rs2[E0.roff + r];
#pragma unroll
            for (int bj = 0; bj < 2; ++bj) {
                const int cl = cl0 + bj * HALF;
                f32x4 v0 = acc[ai][bj][m][0], v1 = acc[ai][bj][m][1];
                if constexpr (MODE == EM_INPROJ) {
                    if (u.pn < 4) {
                        const int col = u.pn * 256 + cl, g = col >> 4, cc = col & 15, chunk = r >> 4, t = r & 15;
                        *(u32x4*)(E.assm + ((size_t)(g * NCHUNK + chunk) * 512 + t * 16 + cc)) = pack8(v0, v1);
                    } else if (u.pn < 22) {
                        const int hidx = (u.pn - 4) * 2 + bj, tensor = hidx / 12, head = hidx - tensor * 12, dcol = cl & 127, dsh = (head >> 2) * 2;
                        int sbase, lsh; if (r < 32768) { sbase = r & ~8191; lsh = 13; } else { sbase = 32768; lsh = 14; }
                        const int local = r - sbase, perm = sbase + ((local & ((1 << dsh) - 1)) << (lsh - dsh)) + (local >> dsh);
                        *(u32x4*)(E.qkv + ((size_t)hidx * M_TOK + perm) * 128 + dcol) = pack8(v0, v1);
                    } else {
#pragma unroll
                        for (int j = 0; j < 4; ++j) { v0[j] = sigmoidf_(v0[j]); v1[j] = sigmoidf_(v1[j]); }
                        *(u32x4*)(E.gates + (size_t)r * GATEW + (u.pn - 22) * 256 + cl) = pack8(v0, v1);
                    }
                } else if constexpr (MODE == EM_SSM_S) {
                    *(u32x4*)(E.S + (size_t)r * 256 + cl) = pack8(v0, v1);
                } else if constexpr (MODE == EM_SSM_Y) {
                    const int g = u.pm / 12, chunk = r - g * NCHUNK, t = cl >> 4, cc = cl & 15, tok = chunk * 16 + t;
#pragma unroll
                    for (int j = 0; j < 4; ++j) { v0[j] = gelu_tanh(v0[j]); v1[j] = gelu_tanh(v1[j]); }
                    *(u32x4*)(E.z + (size_t)tok * SSMW + g * 16 + cc) = pack8(v0, v1);
                } else if constexpr (MODE == EM_GLU) {
                    const int c = u.pn * 256 + cl; const size_t off = (size_t)r * SSMW + c;
                    f32x4 z0, z1; unpack8(*(const u32x4*)(E.z + off), z0, z1);
                    const f32x4 b0 = *(const f32x4*)(E.bglu + c), b1 = *(const f32x4*)(E.bglu + c + 4);
#pragma unroll
                    for (int j = 0; j < 4; ++j) { v0[j] = z0[j] * sigmoidf_(v0[j] + b0[j]); v1[j] = z1[j] * sigmoidf_(v1[j] + b1[j]); }
                    *(u32x4*)(E.yssm + off) = pack8(v0, v1);
                } else if constexpr (MODE == EM_BR1) {
                    const int c = u.pn * 256 + cl;
                    f32x4 g0, g1; unpack8(*(const u32x4*)(E.gates + (size_t)r * GATEW + c), g0, g1);
                    *(u32x4*)(E.mixed + (size_t)r * DM + c) = pack8(g0 * v0, g1 * v1);
                } else if constexpr (MODE == EM_BR2) {
                    const int c = u.pn * 256 + cl;
                    f32x4 g0, g1, m0, m1; unpack8(*(const u32x4*)(E.gates + (size_t)r * GATEW + DM + c), g0, g1);
                    bf16_t* mp = E.mixed + (size_t)r * DM + c; unpack8(*(const u32x4*)mp, m0, m1);
                    *(u32x4*)mp = pack8(m0 + g0 * v0, m1 + g1 * v1);
                } else if constexpr (MODE == EM_OUT) {
                    const int c = u.pn * 256 + cl;
                    const float* xr = (r < 32768 ? E.x0 + (size_t)r * DM : E.x1 + (size_t)(r - 32768) * DM) + c;
                    *(u32x4*)(E.hb + (size_t)r * DM + c) = pack8(*(const f32x4*)xr + v0, *(const f32x4*)(xr + 4) + v1);
                } else if constexpr (MODE == EM_FF1) {
                    const int c = u.pn * 256 + cl;
#pragma unroll
                    for (int j = 0; j < 4; ++j) { const float a = fmaxf(v0[j], 0.f), b = fmaxf(v1[j], 0.f); v0[j] = a * a; v1[j] = b * b; }
                    *(u32x4*)(E.act + (size_t)r * DFF + c) = pack8(v0, v1);
                } else if constexpr (MODE == EM_FF2) {
                    const int c = u.pn * 256 + cl;
                    f32x4 h0, h1; unpack8(*(const u32x4*)(E.hb + (size_t)r * DM + c), h0, h1);
                    *(u32x4*)(E.hfin + (size_t)r * DM + c) = pack8(h0 + v0 * rs2, h1 + v1 * rs2);
                }
            }
        }
}
__device__ __forceinline__ void epi_run(const Epi& E, const f32x4 (&acc)[2][2][4][2], const Unit& u, int wr, int wc, int fr, int fq) {
    switch (E.mode) {
        case EM_INPROJ: epi_body<EM_INPROJ>(E, acc, u, wr, wc, fr, fq); break;
        case EM_SSM_S: epi_body<EM_SSM_S>(E, acc, u, wr, wc, fr, fq); break;
        case EM_SSM_Y: epi_body<EM_SSM_Y>(E, acc, u, wr, wc, fr, fq); break;
        case EM_GLU: epi_body<EM_GLU>(E, acc, u, wr, wc, fr, fq); break;
        case EM_BR1: epi_body<EM_BR1>(E, acc, u, wr, wc, fr, fq); break;
        case EM_BR2: epi_body<EM_BR2>(E, acc, u, wr, wc, fr, fq); break;
        case EM_OUT: epi_body<EM_OUT>(E, acc, u, wr, wc, fr, fq); break;
        case EM_FF1: epi_body<EM_FF1>(E, acc, u, wr, wc, fr, fq); break;
        default: epi_body<EM_FF2>(E, acc, u, wr, wc, fr, fq); break;
    }
}

__device__ __forceinline__ void gemm_phase(LAS unsigned char* lds, const GemmD g, const Sched& S, const Epi& E) {
    const int tid = ltid(), wid = __builtin_amdgcn_readfirstlane(tid >> 6), lane = tid & 63, wr = wid >> 2, wc = wid & 3, fr = lane & 15, fq = lane >> 4;
    const int K = g.K, nt = K / BK;
    unsigned voffA[2], voffB[2];
#pragma unroll
    for (int i = 0; i < 2; ++i) { int R, C; stage_rc(tid * 16 + i * 8192, R, C); const int Rb = (R & ~31) + perm32(R & 31);
        voffA[i] = (unsigned)(R * g.lda + C) * 2u; voffB[i] = (unsigned)(Rb * g.ldb + C) * 2u; }
    const size_t kstep = (size_t)(BK * 2);
    const size_t hstepA = (size_t)HALF * g.lda * 2, tstepA = 2 * hstepA;
    const size_t hstepB = (size_t)HALF * g.ldb * 2, tstepB = 2 * hstepB;
    const unsigned ldsw = (unsigned)wid * 1024u;
    const int aoff = lds_byte(wr * 64 + fr, fq * 8), boff = lds_byte(wc * 32 + fr, fq * 8);
#define PG8_SA(b, h) (((b) * 2 + (h)) * HTB)
#define PG8_SB(b, h) ((4 + (b) * 2 + (h)) * HTB)
#define PG8_STAGE(bufoff, gbase, voff) do { _Pragma("unroll") for (int _i = 0; _i < 2; ++_i) \
        __builtin_amdgcn_global_load_lds((const unsigned*)((const char*)(gbase) + (voff)[_i]), (LAS unsigned*)(lds + (bufoff) + ldsw + _i * 8192), 16, 0, 0); } while (0)
#define PG8_LDA(dst, b, h) do { _Pragma("unroll") for (int m = 0; m < 4; ++m) _Pragma("unroll") for (int k = 0; k < 2; ++k) dst[m][k] = *(const LAS bf16x8*)(lds + PG8_SA(b, h) + aoff + m * 2048 + k * 1024); } while (0)
#define PG8_LDB(dst, b, h) do { _Pragma("unroll") for (int n = 0; n < 2; ++n) _Pragma("unroll") for (int k = 0; k < 2; ++k) dst[n][k] = *(const LAS bf16x8*)(lds + PG8_SB(b, h) + boff + n * 2048 + k * 1024); } while (0)
#define PG8_MMA(ai, bj, At, Bt) do { __builtin_amdgcn_s_setprio(1); _Pragma("unroll") for (int m = 0; m < 4; ++m) _Pragma("unroll") for (int n = 0; n < 2; ++n) _Pragma("unroll") for (int k = 0; k < 2; ++k) \
        acc[ai][bj][m][n] = __builtin_amdgcn_mfma_f32_16x16x32_bf16(Bt[n][k], At[m][k], acc[ai][bj][m][n], 0, 0, 0); __builtin_amdgcn_s_setprio(0); } while (0)
#define PG8_WAIT_V(n) asm volatile("s_waitcnt vmcnt(" #n ")" ::: "memory")
#define PG8_WAIT_L(n) asm volatile("s_waitcnt lgkmcnt(" #n ")" ::: "memory")
#define PG8_BAR __builtin_amdgcn_s_barrier()
#define PG8_SCHED __builtin_amdgcn_sched_barrier(0)
    Unit cur, nxt; int ui = 0;
    if (!S.next(0, cur)) return;
    f32x4 acc[2][2][4][2];
#pragma unroll
    for (int a = 0; a < 2; ++a)
#pragma unroll
        for (int b = 0; b < 2; ++b)
#pragma unroll
            for (int m = 0; m < 4; ++m)
#pragma unroll
                for (int n = 0; n < 2; ++n) acc[a][b][m][n] = (f32x4){0.f, 0.f, 0.f, 0.f};
    bf16x8 At[4][2], B0[2][2], B1[2][2];
    const char* cA = (const char*)g.A + (size_t)cur.pm * tstepA; const char* cB = (const char*)g.Bt + (size_t)cur.pn * tstepB;
    PG8_STAGE(PG8_SB(0, 0), cB, voffB); PG8_STAGE(PG8_SB(0, 1), cB + hstepB, voffB); PG8_STAGE(PG8_SA(0, 0), cA, voffA); PG8_STAGE(PG8_SA(0, 1), cA + hstepA, voffA);
    if (wr == 1) PG8_BAR;
    PG8_WAIT_V(2); PG8_BAR;
    PG8_STAGE(PG8_SB(1, 0), cB + kstep, voffB); PG8_STAGE(PG8_SA(1, 0), cA + kstep, voffA); PG8_STAGE(PG8_SB(1, 1), cB + hstepB + kstep, voffB);
    PG8_WAIT_V(6); PG8_BAR;
    for (;;) {
        const bool has_next = S.next(ui + 1, nxt);
        const char* nA = has_next ? (const char*)g.A + (size_t)nxt.pm * tstepA : cA; const char* nB = has_next ? (const char*)g.Bt + (size_t)nxt.pn * tstepB : cB;
        for (int t = 0; t < nt; t += 2) {
            const bool last = (t == nt - 2);
            const char* a1 = cA + (size_t)(t + 1) * kstep;
            const char* a2 = last ? nA : cA + (size_t)(t + 2) * kstep; const char* b2 = last ? nB : cB + (size_t)(t + 2) * kstep;
            const char* a3 = a2 + kstep; const char* b3 = b2 + kstep;
            PG8_LDB(B0, 0, 0); PG8_LDB(B1, 0, 1); PG8_SCHED; PG8_LDA(At, 0, 0); PG8_STAGE(PG8_SA(1, 1), a1 + hstepA, voffA);
            PG8_WAIT_V(8); PG8_WAIT_L(0); PG8_BAR; PG8_MMA(0, 0, At, B0); PG8_MMA(0, 1, At, B1); PG8_BAR; PG8_SCHED;
            PG8_LDA(At, 0, 1); PG8_STAGE(PG8_SB(0, 0), b2, voffB); PG8_STAGE(PG8_SB(0, 1), b2 + hstepB, voffB); PG8_STAGE(PG8_SA(0, 0), a2, voffA);
            PG8_WAIT_V(8); PG8_WAIT_L(0); PG8_BAR; PG8_MMA(1, 0, At, B0); PG8_MMA(1, 1, At, B1); PG8_BAR; PG8_SCHED;
            PG8_LDB(B0, 1, 0); PG8_LDB(B1, 1, 1); PG8_SCHED; PG8_LDA(At, 1, 0); PG8_STAGE(PG8_SA(0, 1), a2 + hstepA, voffA);
            PG8_WAIT_V(8); PG8_WAIT_L(0); PG8_BAR; PG8_MMA(0, 0, At, B0); PG8_MMA(0, 1, At, B1); PG8_BAR; PG8_SCHED;
            PG8_LDA(At, 1, 1); PG8_STAGE(PG8_SB(1, 0), b3, voffB); PG8_STAGE(PG8_SB(1, 1), b3 + hstepB, voffB); PG8_STAGE(PG8_SA(1, 0), a3, voffA);
            PG8_WAIT_V(8); PG8_WAIT_L(0); PG8_BAR; PG8_MMA(1, 0, At, B0); PG8_MMA(1, 1, At, B1); PG8_BAR; PG8_SCHED;
        }
        if (wr == 0) PG8_BAR;
        epi_run(E, acc, cur, wr, wc, fr, fq);
        if (!has_next) break;
#pragma unroll
        for (int a = 0; a < 2; ++a)
#pragma unroll
            for (int b = 0; b < 2; ++b)
#pragma unroll
                for (int m = 0; m < 4; ++m)
#pragma unroll
                    for (int n = 0; n < 2; ++n) acc[a][b][m][n] = (f32x4){0.f, 0.f, 0.f, 0.f};
        cur = nxt; cA = nA; cB = nB; ++ui;
        if (wr == 1) PG8_BAR;
    }
    PG8_WAIT_V(0);
    PG8_BAR;
#undef PG8_SA
#undef PG8_SB
#undef PG8_STAGE
#undef PG8_LDA
#undef PG8_LDB
#undef PG8_MMA
#undef PG8_WAIT_V
#undef PG8_WAIT_L
#undef PG8_BAR
#undef PG8_SCHED
}
}

#define XB_TMO      128
#define XB_XCNT(j)  (256  + 64 * (j))
#define XB_XSUB(j)  (1280 + 64 * (j))
#define XB_XGEN(j)  (2304 + 64 * (j))
#define XB_TOP      3328
#define XB_TOPGEN   3392
#define XCD_BAR_WORDS 3456
#define XB_SPIN_CAP (1u << 22)
__device__ __forceinline__ unsigned xb_ld(unsigned* p)              { return __hip_atomic_load(p, __ATOMIC_RELAXED, __HIP_MEMORY_SCOPE_AGENT); }
__device__ __forceinline__ unsigned xb_add(unsigned* p, unsigned v) { return __hip_atomic_fetch_add(p, v, __ATOMIC_RELAXED, __HIP_MEMORY_SCOPE_AGENT); }
__device__ __forceinline__ unsigned xb_xcc_id() { return (unsigned)__builtin_amdgcn_s_getreg((3 << 11) | 20) & 0xFu; }
#define XB_SPIN(cond, bar) do { unsigned _sp = 0; while (cond) { __builtin_amdgcn_s_sleep(1); \
    if ((++_sp & 255u) == 0u) { if (xb_ld(&(bar)[XB_TMO])) break; if (_sp > XB_SPIN_CAP) { atomicAdd(&(bar)[XB_TMO], 1u); break; } } } } while (0)
struct XcdBarrier { unsigned* bar; unsigned x; volatile LAS unsigned* st; };
__device__ __forceinline__ XcdBarrier xcd_barrier_post(unsigned* bar, volatile LAS unsigned* st) {
    XcdBarrier b; b.bar = bar; b.x = xb_xcc_id(); b.st = st;
    if (threadIdx.x == 0) (void)xb_add(&bar[XB_XCNT(b.x)], 1u);
    return b;
}
__device__ __forceinline__ void xcd_barrier_complete(unsigned* bar, unsigned x, unsigned& nloc, unsigned& nx) {
    const unsigned G = gridDim.x * gridDim.y * gridDim.z;
    unsigned sum, cnt, mine, sp = 0u;
    for (;;) {
        sum = 0u; cnt = 0u; mine = 0u;
#pragma unroll
        for (unsigned j = 0; j < 16; ++j) { const unsigned c = xb_ld(&bar[XB_XCNT(j)]); sum += c; cnt += (c > 0u) ? 1u : 0u; mine = (j == x) ? c : mine; }
        if (sum == G) break;
        __builtin_amdgcn_s_sleep(1);
        if ((++sp & 255u) == 0u) { if (xb_ld(&bar[XB_TMO])) break; if (sp > XB_SPIN_CAP) { atomicAdd(&bar[XB_TMO], 1u); break; } }
    }
    nloc = mine > 0u ? mine : 1u; nx = cnt > 0u ? cnt : 1u;
}
__device__ __forceinline__ void xcd_barrier(const XcdBarrier& b) {
    asm volatile("s_waitcnt vmcnt(0)" ::: "memory");
    __syncthreads();
    if (threadIdx.x == 0) {
        unsigned* bar = b.bar;
        __builtin_amdgcn_s_waitcnt(0);
        unsigned nloc = b.st[0], nx = b.st[1];
        if (nloc == 0u) { xcd_barrier_complete(bar, b.x, nloc, nx); b.st[0] = nloc; b.st[1] = nx; }
        const unsigned old = xb_add(&bar[XB_XSUB(b.x)], 1u);
        const unsigned gen = old / nloc;
        if (old + 1u == (gen + 1u) * nloc) {
            __builtin_amdgcn_fence(__ATOMIC_RELEASE, "agent");
            asm volatile("s_waitcnt vmcnt(0)" ::: "memory");
            const unsigned og = xb_add(&bar[XB_TOP], 1u);
            const unsigned tg = og / nx;
            if (og + 1u == (tg + 1u) * nx) xb_add(&bar[XB_TOPGEN], 1u);
            else XB_SPIN(xb_ld(&bar[XB_TOPGEN]) == tg, bar);
            __builtin_amdgcn_fence(__ATOMIC_ACQUIRE, "agent");
            xb_add(&bar[XB_XGEN(b.x)], 1u);
            asm volatile("s_waitcnt vmcnt(0)" ::: "memory");
        } else {
            XB_SPIN(xb_ld(&bar[XB_XGEN(b.x)]) == gen, bar);
            __builtin_amdgcn_fence(__ATOMIC_ACQUIRE, "agent");
            asm volatile("s_waitcnt vmcnt(0)" ::: "memory");
        }
    }
    __syncthreads();
}

struct Params { const float* in[22]; float* out; unsigned char* ws; int ph_lo, ph_hi; };

__device__ __forceinline__ void ssm_prep(LAS unsigned char* lds, const Params& p, int g) {
    const float* a_re = p.in[4]; const float* a_im = p.in[5]; const float* log_dt = p.in[6];
    const float* b_re = p.in[7]; const float* b_im = p.in[8]; const float* c_re = p.in[9]; const float* c_im = p.in[10]; const float* dskip = p.in[11];
    LAS float* apow = (LAS float*)lds;
    LAS float* Bb = apow + 2 * 17 * 64 * 2;
    LAS float* Cc = Bb + 2 * 64 * 16 * 2;
    LAS float* Kt = Cc + 2 * 16 * 64 * 2;
    const int tid = ltid();
    for (int idx = tid; idx < 2 * 17 * 64; idx += 512) {
        const int dir = idx / (17 * 64), j = (idx / 64) % 17, pp = idx % 64;
        const float are = a_re[(dir * 64 + g) * 64 + pp], aim = a_im[(dir * 64 + g) * 64 + pp], dt = expf(log_dt[dir * 64 + g]);
        const float x = are * dt * (float)j, y = aim * dt * (float)j; const float mag = expf(x); float s, c; sincosf(y, &s, &c);
        apow[idx * 2] = mag * c; apow[idx * 2 + 1] = mag * s;
    }
    for (int idx = tid; idx < 2 * 64 * 16; idx += 512) {
        const int dir = idx / 1024, pp = (idx / 16) % 64, c = idx % 16;
        const float are = a_re[(dir * 64 + g) * 64 + pp], aim = a_im[(dir * 64 + g) * 64 + pp], dt = expf(log_dt[dir * 64 + g]);
        const float x = are * dt, y = aim * dt; const float ex1 = expm1f(x); float sy, cy; sincosf(y, &sy, &cy); const float sh = sinf(0.5f * y);
        const float nr = ex1 * cy - 2.0f * sh * sh, ni = (ex1 + 1.0f) * sy;
        const float den = are * are + aim * aim; const float qr = (nr * are + ni * aim) / den, qi = (ni * are - nr * aim) / den;
        const float br = b_re[((dir * 64 + g) * 64 + pp) * 16 + c], bi = b_im[((dir * 64 + g) * 64 + pp) * 16 + c];
        Bb[idx * 2] = qr * br - qi * bi; Bb[idx * 2 + 1] = qr * bi + qi * br;
    }
    for (int idx = tid; idx < 2 * 16 * 64; idx += 512) {
        const int dir = idx / 1024, c = (idx / 64) % 16, pp = idx % 64;
        Cc[idx * 2] = c_re[((dir * 64 + g) * 16 + c) * 64 + pp]; Cc[idx * 2 + 1] = c_im[((dir * 64 + g) * 16 + c) * 64 + pp];
    }
    __syncthreads();
    for (int idx = tid; idx < 8192; idx += 512) {
        const int dir = idx >> 12, j = (idx >> 8) & 15, c = (idx >> 4) & 15, c2 = idx & 15;
        float acc = 0.f;
        for (int pp = 0; pp < 64; ++pp) {
            const float ar = apow[((dir * 17 + j) * 64 + pp) * 2], ai = apow[((dir * 17 + j) * 64 + pp) * 2 + 1];
            const float cr = Cc[((dir * 16 + c) * 64 + pp) * 2], ci = Cc[((dir * 16 + c) * 64 + pp) * 2 + 1];
            const float br = Bb[((dir * 64 + pp) * 16 + c2) * 2], bi = Bb[((dir * 64 + pp) * 16 + c2) * 2 + 1];
            const float wr = cr * ar - ci * ai, wi = cr * ai + ci * ar;
            acc += wr * br - wi * bi;
        }
        Kt[idx] = acc;
    }
    bf16_t* bty = (bf16_t*)((unsigned char*)p.out + DO_BTY) + (size_t)g * 256 * 512;
    bf16_t* bts = (bf16_t*)((unsigned char*)p.out + DO_BTS) + (size_t)g * 256 * 256;
    for (int idx = tid; idx < 65536; idx += 512) {
        const int n = idx >> 8, kk = idx & 255, t = n >> 4, c = n & 15, dir = kk >> 7, reim = (kk >> 6) & 1, pp = kk & 63;
        const int j = dir == 0 ? t + 1 : 16 - t;
        const float ar = apow[((dir * 17 + j) * 64 + pp) * 2], ai = apow[((dir * 17 + j) * 64 + pp) * 2 + 1];
        const float cr = Cc[((dir * 16 + c) * 64 + pp) * 2], ci = Cc[((dir * 16 + c) * 64 + pp) * 2 + 1];
        const float wr = cr * ar - ci * ai, wi = cr * ai + ci * ar;
        bty[n * 512 + 256 + kk] = f2bf(reim == 0 ? wr : -wi);
    }
    for (int idx = tid; idx < 65536; idx += 512) {
        const int n = idx >> 8, kk = idx & 255, dir = n >> 7, reim = (n >> 6) & 1, pp = n & 63, s = kk >> 4, c2 = kk & 15;
        const int j = dir == 0 ? 15 - s : s;
        const float ar = apow[((dir * 17 + j) * 64 + pp) * 2], ai = apow[((dir * 17 + j) * 64 + pp) * 2 + 1];
        const float br = Bb[((dir * 64 + pp) * 16 + c2) * 2], bi = Bb[((dir * 64 + pp) * 16 + c2) * 2 + 1];
        const float wr = ar * br - ai * bi, wi = ar * bi + ai * br;
        bts[n * 256 + kk] = f2bf(reim == 0 ? wr : wi);
    }
    __syncthreads();
    for (int idx = tid; idx < 65536; idx += 512) {
        const int n = idx >> 8, kk = idx & 255, t = n >> 4, c = n & 15, s = kk >> 4, c2 = kk & 15;
        float v = 0.f;
        if (s <= t) v += Kt[(((t - s)) * 16 + c) * 16 + c2];
        if (s >= t) v += Kt[((16 + (s - t)) * 16 + c) * 16 + c2];
        if (s == t && c == c2) v += dskip[g * 16 + c];
        bty[n * 512 + kk] = f2bf(v);
    }
    __syncthreads();
}

__device__ __forceinline__ int t5_bucket(int rel) {
    const int ret = rel > 0 ? 16 : 0; const int n = rel < 0 ? -rel : rel;
    if (n < 8) return ret + n;
    int large = 8 + (int)(logf((float)n / 8.0f) / 4.852030263919617f * 8.0f);
    large = large < 15 ? large : 15;
    return ret + large;
}

constexpr int RMS_NR = 4;
template <bool OUT_BF16>
__device__ __forceinline__ void rms_rows(const float* s0, const float* s1, const float* gam, void* dst, int G) {
    const int tid_ = ltid(); const int lane = tid_ & 63, gw = blockIdx.x * 8 + (tid_ >> 6), nw = G * 8;
    for (int r0 = gw; r0 < M_TOK; r0 += RMS_NR * nw) {
        f32x4 v[RMS_NR][8]; float ss[RMS_NR];
#pragma unroll
        for (int q = 0; q < RMS_NR; ++q) {
            const int r = r0 + q * nw, rc = r < M_TOK ? r : r0;
            const float* src = (s1 != nullptr && rc >= 32768) ? s1 + (size_t)(rc - 32768) * DM : s0 + (size_t)rc * DM;
#pragma unroll
            for (int j = 0; j < 8; ++j) v[q][j] = *(const f32x4*)(src + (j * 64 + lane) * 4);
        }
#pragma unroll
        for (int q = 0; q < RMS_NR; ++q) { float a = 0.f;
#pragma unroll
            for (int j = 0; j < 8; ++j) a += v[q][j][0] * v[q][j][0] + v[q][j][1] * v[q][j][1] + v[q][j][2] * v[q][j][2] + v[q][j][3] * v[q][j][3];
#pragma unroll
            for (int o = 32; o >= 1; o >>= 1) a += __shfl_xor(a, o);
            ss[q] = rsqrtf(a * (1.0f / DM) + 1e-6f); }
#pragma unroll
        for (int j = 0; j < 8; ++j) {
            const f32x4 gg = *(const f32x4*)(gam + (j * 64 + lane) * 4);
#pragma unroll
            for (int q = 0; q < RMS_NR; ++q) {
                const int r = r0 + q * nw; if (r >= M_TOK) continue;
                const f32x4 y = v[q][j] * ss[q] * gg;
                if constexpr (OUT_BF16) { u32x2 w; w.x = cvt_pk_bf16(y[0], y[1]); w.y = cvt_pk_bf16(y[2], y[3]); *(u32x2*)((bf16_t*)dst + (size_t)r * DM + (j * 64 + lane) * 4) = w; }
                else *(f32x4*)((float*)dst + (size_t)r * DM + (j * 64 + lane) * 4) = y;
            }
        }
    }
}

template <bool OUT_BF16>
__device__ __forceinline__ void rms_rows_b16(const bf16_t* src, const float* gam, void* dst, int G) {
    const int tid_ = ltid(); const int lane = tid_ & 63, gw = blockIdx.x * 8 + (tid_ >> 6), nw = G * 8;
    for (int r0 = gw; r0 < M_TOK; r0 += RMS_NR * nw) {
        u32x4 v[RMS_NR][4]; float ss[RMS_NR];
#pragma unroll
        for (int q = 0; q < RMS_NR; ++q) {
            const int r = r0 + q * nw, rc = r < M_TOK ? r : r0;
#pragma unroll
            for (int j = 0; j < 4; ++j) v[q][j] = *(const u32x4*)(src + (size_t)rc * DM + (j * 64 + lane) * 8);
        }
#pragma unroll
        for (int q = 0; q < RMS_NR; ++q) { float a = 0.f;
#pragma unroll
            for (int j = 0; j < 4; ++j) { f32x4 x0, x1; unpack8(v[q][j], x0, x1); a += (x0[0] * x0[0] + x0[1] * x0[1]) + (x0[2] * x0[2] + x0[3] * x0[3]) + (x1[0] * x1[0] + x1[1] * x1[1]) + (x1[2] * x1[2] + x1[3] * x1[3]); }
#pragma unroll
            for (int o = 32; o >= 1; o >>= 1) a += __shfl_xor(a, o);
            ss[q] = rsqrtf(a * (1.0f / DM) + 1e-6f); }
#pragma unroll
        for (int j = 0; j < 4; ++j) {
            const f32x4 g0 = *(const f32x4*)(gam + (j * 64 + lane) * 8), g1 = *(const f32x4*)(gam + (j * 64 + lane) * 8 + 4);
#pragma unroll
            for (int q = 0; q < RMS_NR; ++q) {
                const int r = r0 + q * nw; if (r >= M_TOK) continue;
                f32x4 x0, x1; unpack8(v[q][j], x0, x1);
                const f32x4 y0 = x0 * ss[q] * g0, y1 = x1 * ss[q] * g1;
                if constexpr (OUT_BF16) *(u32x4*)((bf16_t*)dst + (size_t)r * DM + (j * 64 + lane) * 8) = pack8(y0, y1);
                else { float* d = (float*)dst + (size_t)r * DM + (j * 64 + lane) * 8; *(f32x4*)d = y0; *(f32x4*)(d + 4) = y1; }
            }
        }
    }
}

__device__ __forceinline__ void rowss_pass(const bf16_t* src, float* rs2, int G) {
    const int tid_ = ltid(); const int lane = tid_ & 63, gw = blockIdx.x * 8 + (tid_ >> 6), nw = G * 8;
    for (int r0 = gw; r0 < M_TOK; r0 += 8 * nw) {
        u32x4 v[8][4];
#pragma unroll
        for (int q = 0; q < 8; ++q) { const int r = r0 + q * nw, rc = r < M_TOK ? r : r0;
#pragma unroll
            for (int j = 0; j < 4; ++j) v[q][j] = *(const u32x4*)(src + (size_t)rc * DM + (j * 64 + lane) * 8); }
#pragma unroll
        for (int q = 0; q < 8; ++q) { float a = 0.f;
#pragma unroll
            for (int j = 0; j < 4; ++j) { f32x4 x0, x1; unpack8(v[q][j], x0, x1); a += (x0[0] * x0[0] + x0[1] * x0[1]) + (x0[2] * x0[2] + x0[3] * x0[3]) + (x1[0] * x1[0] + x1[1] * x1[1]) + (x1[2] * x1[2] + x1[3] * x1[3]); }
#pragma unroll
            for (int o = 32; o >= 1; o >>= 1) a += __shfl_xor(a, o);
            const int r = r0 + q * nw; if (lane == 0 && r < M_TOK) rs2[r] = 1.0f / (a * (1.0f / DM) + 1e-6f); }
    }
}

__device__ __forceinline__ void prep_phase(LAS unsigned char* lds, const Params& p, int G) {
    const int tid = ltid();
    for (int g = blockIdx.x; g < 64; g += G) ssm_prep(lds, p, g);
    if ((int)blockIdx.x == G - 1) {
        float* bt = (float*)(p.ws + WS_BIAS); const float* rb = p.in[20];
        for (int idx = tid; idx < 12 * 129; idx += 512) { const int head = idx / 129, ri = idx % 129, d = 1 << (2 * (head >> 2));
            bt[head * 132 + ri] = rb[t5_bucket((ri - 64) * d) * 12 + head] * 1.4426950408889634f; }
    }
    {
        const float* srcs[7] = {p.in[3], p.in[12], p.in[14], p.in[15], p.in[16], p.in[18], p.in[19]};
        const size_t dofs[7] = {DO_WIN, DO_WGLU, DO_WBS, DO_WBA, DO_WOUT, DO_WFF1, DO_WFF2};
        const int Ks[7] = {2048, 1024, 1024, 512, 2048, 2048, 8192}, Ns[7] = {9728, 1024, 2048, 2048, 2048, 8192, 2048};
        LAS float* tl = (LAS float*)lds;
        int total = 0;
#pragma unroll
        for (int w = 0; w < 7; ++w) total += (Ks[w] / 64) * (Ns[w] / 64);
        const int tskew = G > 128 ? 64 : 0;
        for (int tile0 = (int)blockIdx.x - tskew; tile0 < total; tile0 += 2 * (G - tskew)) {
            if (tile0 < 0) break;
            float ld[2][8]; bf16_t* dsts[2]; int Kq[2], k0q[2], n0q[2]; bool okq[2];
#pragma unroll
            for (int q = 0; q < 2; ++q) {
                const int tile = tile0 + q * (G - tskew); okq[q] = tile < total;
                int w = 0, tt = okq[q] ? tile : tile0; const float* src = srcs[0]; size_t dof = dofs[0]; int K = Ks[0], N = Ns[0];
#pragma unroll
                for (int qq = 0; qq < 6; ++qq) { const int cnt = (Ks[qq] / 64) * (Ns[qq] / 64); if (w == qq && tt >= cnt) { tt -= cnt; w = qq + 1; src = srcs[qq + 1]; dof = dofs[qq + 1]; K = Ks[qq + 1]; N = Ns[qq + 1]; } }
                const int ntn = N / 64, k0 = (tt / ntn) * 64, n0 = (tt % ntn) * 64;
                dsts[q] = (bf16_t*)((unsigned char*)p.out + dof); Kq[q] = K; k0q[q] = k0; n0q[q] = n0;
                const int j = tid & 63, i0 = tid >> 6;
#pragma unroll
                for (int ii = 0; ii < 8; ++ii) { const int i = i0 + 8 * ii; ld[q][ii] = src[(size_t)(k0 + i) * N + n0 + j] * ((w == 5) ? p.in[17][k0 + i] : 1.0f); }
            }
#pragma unroll
            for (int q = 0; q < 2; ++q) { const int j = tid & 63, i0 = tid >> 6;
#pragma unroll
                for (int ii = 0; ii < 8; ++ii) { const int i = i0 + 8 * ii; tl[q * 64 * 65 + i * 65 + j] = ld[q][ii]; } }
            __syncthreads();
#pragma unroll
            for (int q = 0; q < 2; ++q) { if (!okq[q]) continue; const int kp = tid & 31, nn0 = tid >> 5;
#pragma unroll
                for (int jj = 0; jj < 4; ++jj) { const int nn = nn0 + 16 * jj;
                    *(unsigned*)(dsts[q] + (size_t)(n0q[q] + nn) * Kq[q] + k0q[q] + 2 * kp) = cvt_pk_bf16(tl[q * 64 * 65 + (2 * kp) * 65 + nn], tl[q * 64 * 65 + (2 * kp + 1) * 65 + nn]); } }
            __syncthreads();
        }
    }
    rms_rows<true>(p.in[0], p.in[1], p.in[2], (void*)((unsigned char*)p.out + DO_XN), G);
}

constexpr int VS_PITCH = 288, VS_ROWS = 208, VS_BYTES = VS_ROWS * VS_PITCH;
struct AttnItem { int head, dsh, r, pos0, seq_base, m, i0; };
__device__ __forceinline__ AttnItem attn_item(int it) {
    AttnItem a; a.head = it / 768; const int pb = it - a.head * 768, gi = a.head >> 2; a.dsh = gi * 2;
    const int p0 = pb * 64; int lsh; if (p0 < 32768) { a.seq_base = p0 & ~8191; lsh = 13; } else { a.seq_base = 32768; lsh = 14; }
    const int lm = lsh - a.dsh; a.m = 1 << lm; const int local = p0 - a.seq_base; a.r = local >> lm; a.i0 = local - (a.r << lm);
    a.pos0 = a.seq_base + (a.i0 << a.dsh); return a;
}
__device__ __forceinline__ int attn_pair(int j, int c, int G) {
    if ((G & 7) == 0 && (4608 % G) == 0) { const int per_xcd = 4608 / 8, wpx = G >> 3; return (c & 7) * per_xcd + j * wpx + (c >> 3); }
    return j * G + c;
}
__device__ __forceinline__ void attn_load_v(const AttnItem& a, const bf16_t* qkv, int ht, u32x4 (&vreg)[12]) {
#pragma unroll
    for (int pass = 0; pass < 12; ++pass) {
        const int row = pass * 16 + (ht >> 4), ch = ht & 15, ki = a.i0 - 64 + row;
        u32x4 val = (u32x4){0u, 0u, 0u, 0u};
        if (ki >= 0 && ki < a.m) val = *(const u32x4*)(qkv + ((size_t)(24 + a.head) * M_TOK + a.seq_base + a.r * a.m + ki) * 128 + ch * 8);
        vreg[pass] = val;
    }
}
template <bool EDGE>
__device__ __forceinline__ float attn_scores(f32x4 (&sa)[10], const LAS float* bsl, int dl, int kabs0, int m, float scale2) {
    float mx = -3.0e38f;
#pragma unroll
    for (int t9 = 0; t9 < 9; ++t9)
#pragma unroll
        for (int j = 0; j < 4; ++j) {
            bool valid = true;
            if (t9 == 0) valid = (j + dl >= 0);
            if (t9 == 8) valid = (j + dl <= 0);
            if (EDGE) { const int kabs = kabs0 + 16 * t9 + j; valid = valid && (kabs >= 0) && (kabs < m); }
            float sv = sa[t9][j] * scale2 + bsl[16 * t9 + j];
            sv = valid ? sv : -1.0e30f;
            sa[t9][j] = sv; mx = fmaxf(mx, sv);
        }
    return mx;
}
__device__ __forceinline__ void attn_phase(LAS unsigned char* lds, bf16_t* qkv, float* lse, const float* biasT, int G) {
    const int tid = ltid(), wave = __builtin_amdgcn_readfirstlane(tid >> 6), lane = tid & 63, half = wave >> 2, w4 = wave & 3, li = lane & 15, lg = lane >> 4, ht = tid & 255;
    LAS unsigned char* vs = lds + half * VS_BYTES;
    LAS float* bs = (LAS float*)(lds + 2 * VS_BYTES + half * 1024);
    const float scale2 = 0.08838834764831845f * 1.4426950408889634f;
    for (int i = ht; i < 16 * VS_PITCH / 16; i += 256) *(LAS u32x4*)(vs + 192 * VS_PITCH + i * 16) = (u32x4){0u, 0u, 0u, 0u};
    if (ht < 176) bs[ht] = 0.f;
    const int dl = 4 * lg - li, q4 = li >> 2, p4 = li & 3;
    const LAS float* bsl = bs + 16 + dl;
    const LAS unsigned char* vrd = vs + (16 * w4 + 4 * lg + q4) * VS_PITCH + (4 * p4) * 2;
    u32x4 vreg[12];
    const int nrounds = (4608 + G - 1) / G, cwg = blockIdx.x;
    { const int pair0 = attn_pair(0, cwg, G); if (pair0 < 4608) { const AttnItem a = attn_item(pair0 * 2 + half); attn_load_v(a, qkv, ht, vreg); } }
    __syncthreads();
    for (int j = 0; j < nrounds; ++j) {
        const int pair = attn_pair(j, cwg, G); if (pair >= 4608) break;
        const int pairn = (j + 1 < nrounds) ? attn_pair(j + 1, cwg, G) : 4608;
        const AttnItem a = attn_item(pair * 2 + half);
#pragma unroll
        for (int pass = 0; pass < 12; ++pass) *(LAS u32x4*)(vs + (pass * 16 + (ht >> 4)) * VS_PITCH + (ht & 15) * 16) = vreg[pass];
        if (ht < 129) bs[16 + ht] = biasT[a.head * 132 + ht];
        __syncthreads();
        const size_t tokq = (size_t)(a.pos0 + a.r + ((16 * w4 + li) << a.dsh));
        const int pbase = a.seq_base + a.r * a.m;
        bf16_t* qp = qkv + ((size_t)a.head * M_TOK + pbase + a.i0 + 16 * w4 + li) * 128;
        bf16x8 Qf[4];
#pragma unroll
        for (int ks = 0; ks < 4; ++ks) Qf[ks] = *(const bf16x8*)(qp + 32 * ks + 8 * lg);
        const int kbase = a.i0 - 64 + 16 * w4 + li;
        const bf16_t* kcol = qkv + ((size_t)(12 + a.head) * M_TOK + pbase) * 128 + 8 * lg;
        f32x4 sa[10];
        bf16x8 Kf[2][3][4];
#define ATT_LOADK(buf, grp) do { _Pragma("unroll") for (int tt = 0; tt < 3; ++tt) { int ki = kbase + 16 * ((grp) * 3 + tt); ki = ki < 0 ? 0 : (ki > a.m - 1 ? a.m - 1 : ki); \
            const bf16_t* kp = kcol + (size_t)ki * 128; \
            _Pragma("unroll") for (int ks = 0; ks < 4; ++ks) Kf[buf][tt][ks] = *(const bf16x8*)(kp + 32 * ks); } } while (0)
#define ATT_MMAK(buf, grp) do { _Pragma("unroll") for (int tt = 0; tt < 3; ++tt) { f32x4 acc_ = (f32x4){0.f, 0.f, 0.f, 0.f}; \
            _Pragma("unroll") for (int ks = 0; ks < 4; ++ks) acc_ = __builtin_amdgcn_mfma_f32_16x16x32_bf16(Kf[buf][tt][ks], Qf[ks], acc_, 0, 0, 0); sa[(grp) * 3 + tt] = acc_; } } while (0)
        ATT_LOADK(0, 0); ATT_LOADK(1, 1);
        __builtin_amdgcn_sched_barrier(0);
        ATT_MMAK(0, 0);
        __builtin_amdgcn_sched_barrier(0);
        ATT_LOADK(0, 2);
        if (pairn < 4608) { const AttnItem an = attn_item(pairn * 2 + half); attn_load_v(an, qkv, ht, vreg); }
        __builtin_amdgcn_sched_barrier(0);
        ATT_MMAK(1, 1);
        ATT_MMAK(0, 2);
#undef ATT_LOADK
#undef ATT_MMAK
        sa[9] = (f32x4){0.f, 0.f, 0.f, 0.f};
        const int kabs0 = a.i0 - 64 + 16 * w4 + 4 * lg;
        const bool edge = (a.i0 == 0) || (a.i0 + 64 == a.m);
        float mx = edge ? attn_scores<true>(sa, bsl, dl, kabs0, a.m, scale2) : attn_scores<false>(sa, bsl, dl, kabs0, a.m, scale2);
        mx = fmaxf(mx, __shfl_xor(mx, 16)); mx = fmaxf(mx, __shfl_xor(mx, 32));
        float sum = 0.f;
#pragma unroll
        for (int t9 = 0; t9 < 9; ++t9)
#pragma unroll
            for (int j = 0; j < 4; ++j) { const float pv = __builtin_amdgcn_exp2f(sa[t9][j] - mx); sa[t9][j] = pv; sum += pv; }
        sum += __shfl_xor(sum, 16); sum += __shfl_xor(sum, 32);
        bf16x8 Pf[5];
#pragma unroll
        for (int s5 = 0; s5 < 5; ++s5) {
            u32x4 w; w.x = cvt_pk_bf16(sa[2 * s5][0], sa[2 * s5][1]); w.y = cvt_pk_bf16(sa[2 * s5][2], sa[2 * s5][3]);
            w.z = cvt_pk_bf16(sa[2 * s5 + 1][0], sa[2 * s5 + 1][1]); w.w = cvt_pk_bf16(sa[2 * s5 + 1][2], sa[2 * s5 + 1][3]);
            Pf[s5] = __builtin_bit_cast(bf16x8, w);
        }
        const float inv = 1.0f / sum;
        f32x4 o[8];
#pragma unroll
        for (int dt = 0; dt < 8; ++dt) o[dt] = (f32x4){0.f, 0.f, 0.f, 0.f};
#pragma unroll
        for (int s5 = 0; s5 < 5; ++s5) {
            s16x4 va[8], vb[8];
#pragma unroll
            for (int dt = 0; dt < 8; ++dt) {
                va[dt] = __builtin_amdgcn_ds_read_tr16_b64_v4i16((LAS s16x4*)(vrd + (32 * s5) * VS_PITCH + 32 * dt));
                vb[dt] = __builtin_amdgcn_ds_read_tr16_b64_v4i16((LAS s16x4*)(vrd + (32 * s5 + 16) * VS_PITCH + 32 * dt));
            }
#pragma unroll
            for (int dt = 0; dt < 8; ++dt) {
                const bf16x8 Vf = (bf16x8){va[dt][0], va[dt][1], va[dt][2], va[dt][3], vb[dt][0], vb[dt][1], vb[dt][2], vb[dt][3]};
                o[dt] = __builtin_amdgcn_mfma_f32_16x16x32_bf16(Vf, Pf[s5], o[dt], 0, 0, 0);
            }
        }
#pragma unroll
        for (int dt = 0; dt < 8; ++dt) {
            const f32x4 ov = o[dt] * inv;
            u32x2 w; w.x = cvt_pk_bf16(ov[0], ov[1]); w.y = cvt_pk_bf16(ov[2], ov[3]);
            *(u32x2*)(qp + 16 * dt + 4 * lg) = w;
        }
        if (lg == 0) lse[tokq * 12 + a.head] = (mx + __log2f(sum)) * 0.6931471805599453f;
        __syncthreads();
    }
}

__device__ __forceinline__ void scan_merge_phase(const Params& p, int G) {
    const int tid = ltid(), lane = tid & 63;
    const bf16_t* S = (const bf16_t*)((unsigned char*)p.out + DO_XN);
    bf16_t* assm = (bf16_t*)(p.ws + WS_ASSM);
    for (int item = (tid >> 6) * G + blockIdx.x; item < 640; item += 8 * G) {
        const int g = item & 63, dir = (item >> 6) & 1, seq = item >> 7;
        const int n0 = seq < 4 ? seq * 512 : 2048, len = seq < 4 ? 512 : 1024;
        const float are = p.in[4][(dir * 64 + g) * 64 + lane], aim = p.in[5][(dir * 64 + g) * 64 + lane], dt = expf(p.in[6][dir * 64 + g]);
        const float mag = expf(16.0f * are * dt); float sn, cs; sincosf(16.0f * aim * dt, &sn, &cs);
        const float ar = mag * cs, ai = mag * sn;
        float hr = 0.f, hi = 0.f;
        const int nstart = dir == 0 ? n0 : n0 + len - 1; const long step = dir == 0 ? 1 : -1;
        const bf16_t* Sp = S + ((size_t)g * NCHUNK + nstart) * 256 + dir * 128 + lane;
        bf16_t* Ap = assm + ((size_t)g * NCHUNK + nstart) * 512 + 256 + dir * 128 + lane;
        const long sS = step * 256, sA = step * 512;
        float sr[2][16], si[2][16];
#define SCAN_LOAD(buf, b) do { _Pragma("unroll") for (int k = 0; k < 16; ++k) { sr[buf][k] = __uint_as_float((unsigned)Sp[((b) + k) * sS] << 16); si[buf][k] = __uint_as_float((unsigned)Sp[((b) + k) * sS + 64] << 16); } } while (0)
#define SCAN_STEP(buf, b) do { _Pragma("unroll") for (int k = 0; k < 16; ++k) { Ap[((b) + k) * sA] = f2bf(hr); Ap[((b) + k) * sA + 64] = f2bf(hi); \
            const float nr = ar * hr - ai * hi + sr[buf][k], ni = ar * hi + ai * hr + si[buf][k]; hr = nr; hi = ni; } } while (0)
        SCAN_LOAD(0, 0);
        for (int b = 0; b < len; b += 32) {
            SCAN_LOAD(1, b + 16);
            SCAN_STEP(0, b);
            if (b + 32 < len) SCAN_LOAD(0, b + 32);
            SCAN_STEP(1, b + 16);
        }
#undef SCAN_LOAD
#undef SCAN_STEP
    }
    const bf16_t* o = (const bf16_t*)(p.ws + WS_QKV); const float* lse = (const float*)(p.ws + WS_LSE);
    bf16_t* ya = (bf16_t*)((unsigned char*)p.out + DO_YATT);
    const int nsw = (640 + G - 1) / G, wv = tid >> 6;
    const int mthreads = nsw < 8 ? (8 - nsw) * 64 : 512, mtid = nsw < 8 ? tid - nsw * 64 : tid;
    if (nsw < 8 && wv < nsw) return;
    for (int idx0 = blockIdx.x * mthreads + mtid; idx0 < M_TOK * 64; idx0 += 2 * G * mthreads) {
        f32x4 a0[2], a1[2], b0[2], b1[2], c0[2], c1[2]; float w0[2], w1[2], w2[2];
#pragma unroll
        for (int q = 0; q < 2; ++q) {
            const int idx = idx0 + q * G * mthreads < M_TOK * 64 ? idx0 + q * G * mthreads : idx0;
            const int tok = idx >> 6, hh = (idx >> 4) & 3, ch = idx & 15;
            const float l0 = lse[tok * 12 + hh], l1 = lse[tok * 12 + 4 + hh], l2 = lse[tok * 12 + 8 + hh];
            int sbase, lsh; if (tok < 32768) { sbase = tok & ~8191; lsh = 13; } else { sbase = 32768; lsh = 14; }
            const int local = tok - sbase;
            const int p1 = sbase + ((local & 3) << (lsh - 2)) + (local >> 2), p2 = sbase + ((local & 15) << (lsh - 4)) + (local >> 4);
            unpack8(*(const u32x4*)(o + ((size_t)hh * M_TOK + tok) * 128 + ch * 8), a0[q], a1[q]);
            unpack8(*(const u32x4*)(o + ((size_t)(4 + hh) * M_TOK + p1) * 128 + ch * 8), b0[q], b1[q]);
            unpack8(*(const u32x4*)(o + ((size_t)(8 + hh) * M_TOK + p2) * 128 + ch * 8), c0[q], c1[q]);
            const float mx = fmaxf(l0, fmaxf(l1, l2)); w0[q] = __expf(l0 - mx); w1[q] = __expf(l1 - mx); w2[q] = __expf(l2 - mx);
            const float inv = 1.0f / (w0[q] + w1[q] + w2[q]); w0[q] *= inv; w1[q] *= inv; w2[q] *= inv;
        }
#pragma unroll
        for (int q = 0; q < 2; ++q) {
            const int idx = idx0 + q * G * mthreads; if (idx >= M_TOK * 64) continue;
            const int tok = idx >> 6, hh = (idx >> 4) & 3, ch = idx & 15;
            *(u32x4*)(ya + (size_t)tok * 512 + hh * 128 + ch * 8) = pack8(a0[q] * w0[q] + b0[q] * w1[q] + c0[q] * w2[q], a1[q] * w0[q] + b1[q] * w1[q] + c1[q] * w2[q]);
        }
    }
}

template <bool COOP>
__global__ void __launch_bounds__(512, 2) fwd_kernel(Params p) {
    extern __shared__ __attribute__((aligned(16))) unsigned char lds_raw[];
    LAS unsigned char* lds = (LAS unsigned char*)lds_raw;
    const int G = gridDim.x;
    XcdBarrier xb; xb.bar = (unsigned*)(p.ws + WS_BAR); xb.x = 0; xb.st = (volatile LAS unsigned*)(lds + 131072);
    bool posted = false;
    if constexpr (COOP) {
        if (threadIdx.x < 4) ((LAS unsigned*)(lds + 131072))[threadIdx.x] = 0u;
        if (blockIdx.x == 0) for (int i = threadIdx.x; i < XCD_BAR_WORDS; i += 512) __hip_atomic_store(xb.bar + i, 0u, __ATOMIC_RELAXED, __HIP_MEMORY_SCOPE_AGENT);
        __syncthreads();
    }
    for (int ph = p.ph_lo; ph < p.ph_hi; ++ph)
    for (int rep = 0; rep < (((PROBE_MASK >> ph) & 1u) ? 2 : 1); ++rep) {
        if ((ph > p.ph_lo || rep > 0) && !(COOP && ph == 7)) { if constexpr (COOP) {
            if (!posted) { cg::this_grid().sync(); xb = xcd_barrier_post((unsigned*)(p.ws + WS_BAR), (volatile LAS unsigned*)(lds + 131072)); posted = true; }
            else xcd_barrier(xb);
        } }
        unsigned char* ws = lptr(p.ws); unsigned char* dob = lptr((unsigned char*)p.out);
        const bf16_t* hb16 = (const bf16_t*)(ws + WS_GATES); const bf16_t* hfin16 = hb16 + (size_t)M_TOK * DM;
        if (ph == 0) { prep_phase(lds, p, G); continue; }
        if (ph == 3) { scan_merge_phase(p, G); continue; }
        if (ph == 9) rowss_pass(hb16, (float*)(ws + WS_RS2), G);
        if (ph == N_PHASES - 1) { rms_rows_b16<false>(hfin16, p.in[21], (void*)p.out, G); continue; }
        bf16_t* assm = (bf16_t*)(ws + WS_ASSM); bf16_t* z = (bf16_t*)(dob + DO_XN);
        pg8::GemmD g; pg8::Sched S; pg8::Epi E;
        E.ws = ws; E.dob = dob; E.bglu = p.in[13]; E.x0 = p.in[0]; E.x1 = p.in[1]; E.hoff = 0; E.roff = 0;
        S.G = G; S.c = blockIdx.x; S.ssm = 0; S.nM = M_TOK / 256;
        if (ph == 1) { g = {z, (const bf16_t*)(dob + DO_WIN), DM, DM, DM}; S.nN = 38; E.mode = pg8::EM_INPROJ; }
        else if (ph == 2) { g = {assm, (const bf16_t*)(dob + DO_BTS), 512, 256, 256}; S.ssm = 1; S.nM = 768; S.nN = 1; E.mode = pg8::EM_SSM_S; }
        else if (ph == 4) { g = {assm, (const bf16_t*)(dob + DO_BTY), 512, 512, 512}; S.ssm = 1; S.nM = 768; S.nN = 1; E.mode = pg8::EM_SSM_Y; }
        else if (ph == 5) { g = {z, (const bf16_t*)(dob + DO_WGLU), SSMW, SSMW, SSMW}; S.nN = 4; E.mode = pg8::EM_GLU; }
        else if (ph == 6) { g = {z + (size_t)M_TOK * SSMW, (const bf16_t*)(dob + DO_WBS), SSMW, SSMW, SSMW}; S.nN = 8; E.mode = pg8::EM_BR1; }
        else if (ph == 7) { g = {(const bf16_t*)(dob + DO_YATT), (const bf16_t*)(dob + DO_WBA), 512, 512, 512}; S.nN = 8; E.mode = pg8::EM_BR2; }
        else if (ph == 8) { g = {(const bf16_t*)(ws + WS_QKV), (const bf16_t*)(dob + DO_WOUT), DM, DM, DM}; S.nN = 8; E.mode = pg8::EM_OUT; }
        else {
            const int c = (ph - 9) >> 1;
            if (((ph - 9) & 1) == 0) { g = {hb16 + (size_t)c * FF_ROWS * DM, (const bf16_t*)(dob + DO_WFF1), DM, DM, DM}; S.nM = FF_ROWS / 256; S.nN = 32; E.mode = pg8::EM_FF1; }
            else { g = {(const bf16_t*)(ws + WS_QKV), (const bf16_t*)(dob + DO_WFF2), DFF, DFF, DFF}; S.nM = FF_ROWS / 256; S.nN = 8; E.mode = pg8::EM_FF2; E.hoff = (size_t)c * FF_ROWS * DM; E.roff = c * FF_ROWS; }
        }
        S.nwg = S.nM * S.nN;
        pg8::gemm_phase(lds, g, S, E);
        if (ph == 2) attn_phase(lds, (bf16_t*)(ws + WS_QKV), (float*)(ws + WS_LSE), (const float*)(ws + WS_BIAS), G);
    }
}

extern "C" void kernel_launch(void* const* d_in, const int* in_sizes, int n_in, void* d_out, int out_size, void* d_ws, size_t ws_size, hipStream_t stream) {
    static int grid = 0;
    if (grid == 0) {
        if (n_in != 22 || out_size != M_TOK * DM || ws_size < WS_END) { fprintf(stderr, "kernel_launch: unexpected shapes (n_in %d, out %d, ws %zu, need %zu)\n", n_in, out_size, ws_size, (size_t)WS_END); grid = -1; return; }
        int dev = 0, cus = 0, per_cu = 0;
        (void)hipGetDevice(&dev); (void)hipDeviceGetAttribute(&cus, hipDeviceAttributeMultiprocessorCount, dev);
        (void)hipFuncSetAttribute((const void*)fwd_kernel<true>, hipFuncAttributeMaxDynamicSharedMemorySize, LDS_BYTES);
        (void)hipFuncSetAttribute((const void*)fwd_kernel<false>, hipFuncAttributeMaxDynamicSharedMemorySize, LDS_BYTES);
        (void)hipOccupancyMaxActiveBlocksPerMultiprocessor(&per_cu, (const void*)fwd_kernel<true>, 512, LDS_BYTES);
        if (per_cu < 1) per_cu = 1;
        (void)hipGetLastError();
        grid = cus * per_cu; if (grid > 256) grid = 256; if (grid < 1) grid = 256;
    }
    if (grid < 0) return;
    Params p{};
    for (int i = 0; i < 22; ++i) p.in[i] = (const float*)d_in[i];
    p.out = (float*)d_out; p.ws = (unsigned char*)d_ws;
#if MK_COOP
    p.ph_lo = 0; p.ph_hi = N_PHASES;
    void* args[] = {&p};
    hipError_t e = hipLaunchCooperativeKernel((const void*)fwd_kernel<true>, dim3(grid), dim3(512), args, LDS_BYTES, stream);
    if (e != hipSuccess) fprintf(stderr, "cooperative launch failed: %s (grid %d)\n", hipGetErrorString(e), grid);
#else
    for (int ph = 0; ph < N_PHASES; ++ph) {
        p.ph_lo = ph; p.ph_hi = ph + 1;
        hipLaunchKernelGGL(fwd_kernel<false>, dim3(grid), dim3(512), LDS_BYTES, stream, p);
    }
#endif
}
```
